# Optimizing an MI355X kernel written in HIP

```python
import jax, jax.numpy as jnp
from jax import lax
import numpy as np

D_MODEL = 1024
BATCH = 16
SEQ = 2048
DEPTH = 2

D_FF = 2816
NORM_EPS = 1e-6
FFN_RES_WEIGHT = 0.5

D_CONV = D_MODEL
CONV_WIDTH = 31
CONV_LN_EPS = 1e-5

MLA_HEADS = 8
Q_LORA = 512
KV_LORA = 256
QK_NOPE = 128
QK_ROPE = 64
V_HEAD = 128
ROPE_THETA = 10000.0
Q_BLOCK = 128

IN_COLS = 2 * D_CONV + Q_LORA + KV_LORA + QK_ROPE
OUT_COLS = D_CONV + MLA_HEADS * V_HEAD

RWKV_HEAD = 64
RWKV_HEADS = D_MODEL // RWKV_HEAD
DECAY_LORA = 64
AAA_LORA = 64
GATE_LORA = 128
RWKV_GN_EPS = 64e-5
N_SHIFT_MIX = 6

kernel_name = 'hybrid_conv_mla_rwkv7_macaron'


def rms_norm(x, g, eps=NORM_EPS):
    xf = x.astype(jnp.float32)
    y = xf * lax.rsqrt(jnp.mean(xf * xf, axis=-1, keepdims=True) + eps)
    return (y * g.astype(jnp.float32)).astype(x.dtype)


def swiglu_ffn(h, w_gate, w_up, w_down):
    return (jax.nn.silu(h @ w_gate) * (h @ w_up)) @ w_down


def rope_tables(positions):
    inv_freq = 1.0 / (ROPE_THETA ** (jnp.arange(0, QK_ROPE, 2, dtype=jnp.float32) / QK_ROPE))
    ang = positions.astype(jnp.float32)[..., None] * inv_freq
    return jnp.cos(ang), jnp.sin(ang)


def apply_rope(x, cos, sin):
    xf = x.astype(jnp.float32)
    x1, x2 = jnp.split(xf, 2, axis=-1)
    return jnp.concatenate([x1 * cos - x2 * sin, x1 * sin + x2 * cos], axis=-1).astype(x.dtype)


def conformer_conv(a, gate, conv_w, conv_b, ln_g, ln_b):
    h = a * jax.nn.sigmoid(gate)
    h = lax.conv_general_dilated(
        h, conv_w[:, None, :].astype(h.dtype), window_strides=(1,),
        padding=[(CONV_WIDTH - 1, 0)],
        dimension_numbers=('NWC', 'WIO', 'NWC'),
        feature_group_count=D_CONV) + conv_b
    hf = h.astype(jnp.float32)
    mu = jnp.mean(hf, axis=-1, keepdims=True)
    var = jnp.mean(jnp.square(hf - mu), axis=-1, keepdims=True)
    hn = (hf - mu) * lax.rsqrt(var + CONV_LN_EPS) * ln_g + ln_b
    return jax.nn.silu(hn).astype(a.dtype)


def mla_attention(q_nope, q_pe, k_nope, k_pe, v):
    seq = q_nope.shape[1]
    scale = (QK_NOPE + QK_ROPE) ** -0.5
    outs = []
    for blk in range(seq // Q_BLOCK):
        q0, q1 = blk * Q_BLOCK, (blk + 1) * Q_BLOCK
        s = (jnp.einsum('bqhd,bkhd->bhqk', q_nope[:, q0:q1], k_nope[:, :q1])
             + jnp.einsum('bqhr,bkr->bhqk', q_pe[:, q0:q1], k_pe[:, :q1]))
        s = s.astype(jnp.float32) * scale
        causal = (q0 + jnp.arange(Q_BLOCK))[:, None] >= jnp.arange(q1)[None, :]
        p = jax.nn.softmax(jnp.where(causal, s, -jnp.inf), axis=-1).astype(v.dtype)
        outs.append(jnp.einsum('bhqk,bkhd->bqhd', p, v[:, :q1]))
    return jnp.concatenate(outs, axis=1)


def conv_mla_mixer(h, cos, sin, w_in, conv_w, conv_b, conv_ln_g, conv_ln_b,
                   q_norm, w_uq, kv_norm, w_ukv, w_out):
    b, s, _ = h.shape
    z = h @ w_in
    conv_a, conv_gate, q_lat, kv_lat, k_pe = jnp.split(
        z, [D_CONV, 2 * D_CONV, 2 * D_CONV + Q_LORA, 2 * D_CONV + Q_LORA + KV_LORA], axis=-1)
    conv_out = conformer_conv(conv_a, conv_gate, conv_w, conv_b, conv_ln_g, conv_ln_b)
    q = (rms_norm(q_lat, q_norm) @ w_uq).reshape(b, s, MLA_HEADS, QK_NOPE + QK_ROPE)
    q_nope = q[..., :QK_NOPE]
    q_pe = apply_rope(q[..., QK_NOPE:], cos[:, :, None, :], sin[:, :, None, :])
    kv = (rms_norm(kv_lat, kv_norm) @ w_ukv).reshape(b, s, MLA_HEADS, QK_NOPE + V_HEAD)
    k_nope, v = kv[..., :QK_NOPE], kv[..., QK_NOPE:]
    k_pe = apply_rope(k_pe, cos, sin)
    attn = mla_attention(q_nope, q_pe, k_nope, k_pe, v).reshape(b, s, MLA_HEADS * V_HEAD)
    return jnp.concatenate([conv_out, attn], axis=-1) @ w_out


def rwkv7_time_mix(h, time_mu, w_r, w_k, w_v, w_o, w0, w1, w2, a0, a1, a2,
                   g1, g2, k_k, k_a, r_k, ln_x_g, ln_x_b):
    b, s, d = h.shape
    f32 = jnp.float32
    hh = jnp.pad(h, ((0, 0), (1, 0), (0, 0)))[:, :-1] - h
    xr, xw, xk, xv, xa, xg = [h + hh * time_mu[i] for i in range(N_SHIFT_MIX)]
    r = (xr @ w_r).astype(f32)
    k = (xk @ w_k).astype(f32)
    v = (xv @ w_v).astype(f32)
    w_log = -jax.nn.softplus(-(w0 + jnp.tanh(xw @ w1) @ w2).astype(f32)) - 0.5
    decay = jnp.exp(-jnp.exp(w_log))
    a = jax.nn.sigmoid((a0 + (xa @ a1) @ a2).astype(f32))
    g = (jax.nn.sigmoid(xg @ g1) @ g2).astype(f32)
    kk = (k * k_k).reshape(b, s, RWKV_HEADS, RWKV_HEAD)
    kk = kk / jnp.maximum(jnp.linalg.norm(kk, axis=-1, keepdims=True), 1e-12)
    k = k * (1.0 + (a - 1.0) * k_a)
    heads = lambda t: t.reshape(b, s, RWKV_HEADS, RWKV_HEAD)
    r, k, v, decay, a = heads(r), heads(k), heads(v), heads(decay), heads(a)

    def step(state, inp):
        r_t, w_t, k_t, v_t, kk_t, a_t = inp
        sa = jnp.einsum('bhvk,bhk->bhv', state, -kk_t)
        state = (state * w_t[:, :, None, :]
                 + sa[..., None] * (kk_t * a_t)[:, :, None, :]
                 + v_t[..., None] * k_t[:, :, None, :])
        return state, jnp.einsum('bhvk,bhk->bhv', state, r_t)

    xs = tuple(jnp.moveaxis(t, 1, 0) for t in (r, decay, k, v, kk, a))
    state0 = jnp.zeros((b, RWKV_HEADS, RWKV_HEAD, RWKV_HEAD), f32)
    _, y = lax.scan(step, state0, xs)
    y = jnp.moveaxis(y, 0, 1)
    mu = jnp.mean(y, axis=-1, keepdims=True)
    var = jnp.mean(jnp.square(y - mu), axis=-1, keepdims=True)
    y = ((y - mu) * lax.rsqrt(var + RWKV_GN_EPS)).reshape(b, s, d) * ln_x_g + ln_x_b
    bonus = jnp.sum(r * k * r_k, axis=-1, keepdims=True) * v
    y = y + bonus.reshape(b, s, d)
    return (y * g).astype(h.dtype) @ w_o


def setup_inputs(seed: int = 0) -> dict:
    key = jax.random.key(seed)
    keys = iter(jax.random.split(key, 48))
    f32 = jnp.float32
    nrm = lambda shape, scale: jax.random.normal(next(keys), shape, f32) * scale
    gain = lambda shape: 1.0 + nrm(shape, 0.02)
    ne, no = (DEPTH + 1) // 2, DEPTH // 2
    x = jax.random.normal(next(keys), (BATCH, SEQ, D_MODEL), f32)
    offset = jax.random.randint(next(keys), (BATCH, 1), 0, 1024, dtype=jnp.int32)
    positions = jnp.arange(SEQ, dtype=jnp.int32)[None, :] + offset
    return {
        'x': x,
        'positions': positions,
        'ffn_norm': gain((DEPTH, 2, D_MODEL)),
        'ffn_w_gate': nrm((DEPTH, 2, D_MODEL, D_FF), D_MODEL ** -0.5),
        'ffn_w_up': nrm((DEPTH, 2, D_MODEL, D_FF), D_MODEL ** -0.5),
        'ffn_w_down': nrm((DEPTH, 2, D_FF, D_MODEL), D_FF ** -0.5),
        'mix_norm_even': gain((ne, D_MODEL)),
        'w_in': nrm((ne, D_MODEL, IN_COLS), D_MODEL ** -0.5),
        'conv_w': nrm((ne, CONV_WIDTH, D_CONV), CONV_WIDTH ** -0.5),
        'conv_b': nrm((ne, D_CONV), 0.01),
        'conv_ln_g': gain((ne, D_CONV)),
        'conv_ln_b': nrm((ne, D_CONV), 0.01),
        'q_norm': gain((ne, Q_LORA)),
        'w_uq': nrm((ne, Q_LORA, MLA_HEADS * (QK_NOPE + QK_ROPE)), Q_LORA ** -0.5),
        'kv_norm': gain((ne, KV_LORA)),
        'w_ukv': nrm((ne, KV_LORA, MLA_HEADS * (QK_NOPE + V_HEAD)), KV_LORA ** -0.5),
        'w_out': nrm((ne, OUT_COLS, D_MODEL), OUT_COLS ** -0.5),
        'mix_norm_odd': gain((no, D_MODEL)),
        'time_mu': jax.random.uniform(next(keys), (no, N_SHIFT_MIX, D_MODEL), f32),
        'w_r': nrm((no, D_MODEL, D_MODEL), D_MODEL ** -0.5),
        'w_k': nrm((no, D_MODEL, D_MODEL), D_MODEL ** -0.5),
        'w_v': nrm((no, D_MODEL, D_MODEL), D_MODEL ** -0.5),
        'w_o': nrm((no, D_MODEL, D_MODEL), D_MODEL ** -0.5),
        'w0': jax.random.uniform(next(keys), (no, D_MODEL), f32, -5.0, -0.5),
        'w1': nrm((no, D_MODEL, DECAY_LORA), D_MODEL ** -0.5),
        'w2': nrm((no, DECAY_LORA, D_MODEL), DECAY_LORA ** -0.5),
        'a0': nrm((no, D_MODEL), 0.1),
        'a1': nrm((no, D_MODEL, AAA_LORA), D_MODEL ** -0.5),
        'a2': nrm((no, AAA_LORA, D_MODEL), AAA_LORA ** -0.5),
        'g1': nrm((no, D_MODEL, GATE_LORA), D_MODEL ** -0.5),
        'g2': nrm((no, GATE_LORA, D_MODEL), GATE_LORA ** -0.5),
        'k_k': 0.85 + nrm((no, D_MODEL), 0.02),
        'k_a': gain((no, D_MODEL)),
        'r_k': nrm((no, RWKV_HEADS, RWKV_HEAD), 0.1),
        'ln_x_g': gain((no, D_MODEL)),
        'ln_x_b': nrm((no, D_MODEL), 0.01),
        'final_norm': gain((D_MODEL,)),
    }


def reference(x, positions, ffn_norm, ffn_w_gate, ffn_w_up, ffn_w_down,
              mix_norm_even, w_in, conv_w, conv_b, conv_ln_g, conv_ln_b,
              q_norm, w_uq, kv_norm, w_ukv, w_out,
              mix_norm_odd, time_mu, w_r, w_k, w_v, w_o, w0, w1, w2,
              a0, a1, a2, g1, g2, k_k, k_a, r_k, ln_x_g, ln_x_b, final_norm):
    cos, sin = rope_tables(positions)
    for layer in range(DEPTH):
        x = x + FFN_RES_WEIGHT * swiglu_ffn(rms_norm(x, ffn_norm[layer, 0]),
                                            ffn_w_gate[layer, 0], ffn_w_up[layer, 0],
                                            ffn_w_down[layer, 0])
        if layer % 2 == 0:
            e = layer // 2
            x = x + conv_mla_mixer(rms_norm(x, mix_norm_even[e]), cos, sin, w_in[e],
                                   conv_w[e], conv_b[e], conv_ln_g[e], conv_ln_b[e],
                                   q_norm[e], w_uq[e], kv_norm[e], w_ukv[e], w_out[e])
        else:
            o = layer // 2
            x = x + rwkv7_time_mix(rms_norm(x, mix_norm_odd[o]), time_mu[o], w_r[o], w_k[o],
                                   w_v[o], w_o[o], w0[o], w1[o], w2[o], a0[o], a1[o],
                                   a2[o], g1[o], g2[o], k_k[o], k_a[o], r_k[o],
                                   ln_x_g[o], ln_x_b[o])
        x = x + FFN_RES_WEIGHT * swiglu_ffn(rms_norm(x, ffn_norm[layer, 1]),
                                            ffn_w_gate[layer, 1], ffn_w_up[layer, 1],
                                            ffn_w_down[layer, 1])
    return rms_norm(x, final_norm)
```

```cpp
#include <hip/hip_runtime.h>
#include <hip/hip_cooperative_groups.h>
#include <cstdio>
#include <cstdint>
#include <cstring>
namespace cg = cooperative_groups;

#define LAS __attribute__((address_space(3)))
typedef unsigned short bf16_t;
typedef short bf16x8 __attribute__((ext_vector_type(8)));
typedef float f32x4 __attribute__((ext_vector_type(4)));
typedef float f32x2 __attribute__((ext_vector_type(2)));
typedef float f32x16 __attribute__((ext_vector_type(16)));
typedef unsigned u32x4 __attribute__((ext_vector_type(4)));
typedef unsigned u32x2 __attribute__((ext_vector_type(2)));

constexpr int T_ = 32768, D_ = 1024, FF_ = 2816, S_ = 2048, NB_ = 16;
constexpr float LOG2E = 1.4426950408889634f;
constexpr size_t MiB = 1u << 20;
constexpr size_t WS_FFN = 0;
constexpr size_t FFN_STRIDE = 16 * MiB + MiB / 2, FFN_DN_OFF = 11 * MiB;
constexpr size_t WS_WIN = 66 * MiB, WS_WUQ = 72 * MiB, WS_WKN = 73 * MiB + MiB / 2, WS_WVT = 74 * MiB, WS_WOUT = 74 * MiB + MiB / 2;
constexpr size_t WS_WR = 78 * MiB + MiB / 2, WS_WK = 80 * MiB + MiB / 2, WS_WV = 82 * MiB + MiB / 2, WS_WO = 84 * MiB + MiB / 2;
constexpr size_t WS_WL1 = 86 * MiB + MiB / 2, WS_WL2 = 88 * MiB;
constexpr size_t WS_XN = 96 * MiB;
constexpr size_t WS_VT = 96 * MiB;
constexpr size_t WS_HID = 160 * MiB;
constexpr size_t WS_U = 160 * MiB;
constexpr size_t WS_Q = 160 * MiB;
constexpr size_t WS_ZL = 288 * MiB;
constexpr size_t WS_ATT = 288 * MiB;
constexpr size_t WS_CONV = 352 * MiB;
constexpr size_t WS_KN = 416 * MiB;
constexpr size_t WS_KPE = 480 * MiB;
constexpr size_t WS_ROPE = 484 * MiB;
constexpr size_t WS_R = 96 * MiB, WS_K = 160 * MiB, WS_V = 224 * MiB;
constexpr size_t WS_XR = 288 * MiB, WS_XK = 352 * MiB, WS_XV = 416 * MiB;
constexpr size_t WS_XWAG = 288 * MiB;
constexpr size_t WS_WAG = 288 * MiB;
constexpr size_t WS_L1 = 480 * MiB;
constexpr size_t WS_END = 512 * MiB;

constexpr int LDS_BYTES = 147456;
constexpr int NJOBS = 40;

struct Job { const float* src; bf16_t* dst; int ldsrc, c0, sstride, G, lddst, r0, dstride, dk0, Kc, Nc, item0; float scale; };
struct Params {
    const float* in[37];
    float* out; unsigned char* ws;
    int njobs, nitems, ph_lo, ph_hi;
    Job jobs[NJOBS];
};

__device__ __forceinline__ unsigned pk_bf16(float lo, float hi) { typedef __bf16 b2 __attribute__((ext_vector_type(2))); f32x2 v = {lo, hi}; b2 b = __builtin_convertvector(v, b2); return __builtin_bit_cast(unsigned, b); }
__device__ __forceinline__ unsigned pk_f16(float lo, float hi) { typedef _Float16 h2 __attribute__((ext_vector_type(2))); h2 b = {(_Float16)lo, (_Float16)hi}; return __builtin_bit_cast(unsigned, b); }
__device__ __forceinline__ float bf_lo(unsigned u) { return __uint_as_float(u << 16); }
__device__ __forceinline__ float bf_hi(unsigned u) { return __uint_as_float(u & 0xffff0000u); }
__device__ __forceinline__ float h_lo(unsigned u) { typedef _Float16 h2 __attribute__((ext_vector_type(2))); h2 b = __builtin_bit_cast(h2, u); return (float)b[0]; }
__device__ __forceinline__ float h_hi(unsigned u) { typedef _Float16 h2 __attribute__((ext_vector_type(2))); h2 b = __builtin_bit_cast(h2, u); return (float)b[1]; }
__device__ __forceinline__ float fexp2(float x) { return __builtin_amdgcn_exp2f(x); }
__device__ __forceinline__ float frcp(float x) { return __builtin_amdgcn_rcpf(x); }
__device__ __forceinline__ float sigmoidf_(float x) { return frcp(1.0f + fexp2(-x * LOG2E)); }
__device__ __forceinline__ float wave_sum(float v) {
#pragma unroll
    for (int o = 1; o < 64; o <<= 1) v += __shfl_xor(v, o);
    return v;
}
__device__ __forceinline__ float sum16(float v) {
#pragma unroll
    for (int o = 1; o < 16; o <<= 1) v += __shfl_xor(v, o);
    return v;
}
#define LDS_WAIT() asm volatile("s_waitcnt lgkmcnt(0)" ::: "memory")

namespace pg8 {
constexpr int BM = 256, BK = 64, HALF = 128, HTB = HALF * BK * 2, STAGE_BYTES = 8 * HTB, NXCD = 8, WGM = 8;
__host__ __device__ __forceinline__ int lds_byte(int r, int c) { const int st = (r >> 4) * 2 + (c >> 5), rr = r & 15, cc = c & 31, ob = rr * 64 + cc * 2; return st * 1024 + (ob ^ (((ob >> 9) & 1) << 5)); }
__host__ __device__ __forceinline__ void stage_rc(int b, int& R, int& C) { const int st = b / 1024, sb = b % 1024, swz = sb ^ (((sb >> 9) & 1) << 5); R = (st >> 1) * 16 + swz / 64; C = (st & 1) * 32 + (swz % 64) / 2; }
__host__ __device__ __forceinline__ int perm32(int rho) { const int n = rho >> 4, i = rho & 15; return 8 * (i >> 2) + 4 * n + (i & 3); }

struct Unit { int pm, pn; };
struct Gemm { const bf16_t* A; const bf16_t* Bt; int M, N, K, lda, ldb; };

struct StaticOrder {
    int nM, nN, nwg, G, c;
    __device__ void init(int M, int N, int G_, int c_) { nM = M / BM; nN = N / BM; nwg = nM * nN; G = G_; c = c_; }
    __device__ bool next(int i, Unit& u) const {
        const long L = (long)i * G + c; if (L >= nwg) return false;
        int wgid = (int)L; { const int q = nwg / NXCD, r = nwg % NXCD, xcd = wgid % NXCD, off = wgid / NXCD; wgid = (xcd < r ? xcd * (q + 1) : r * (q + 1) + (xcd - r) * q) + off; }
        const int nig = WGM * nN, gid = wgid / nig, fm = gid * WGM, gsz = (nM - fm) < WGM ? (nM - fm) : WGM;
        u.pm = fm + ((wgid % nig) % gsz); u.pn = (wgid % nig) / gsz; return true;
    }
};

typedef f32x4 Acc[2][2][4][2];

struct EpiStore {
    bf16_t* O; int ldc; int split_pn; bf16_t* O2; int ldc2;
    __device__ __forceinline__ void operator()(const Acc& acc, const Unit& u, int wr, int wc, int fr, int fq) const {
        bf16_t* base = O; int ld = ldc; int colt = u.pn * BM;
        if (u.pn >= split_pn) { base = O2; ld = ldc2; colt = (u.pn - split_pn) * BM; }
        const int row0 = u.pm * BM + wr * 64 + fr, col0 = colt + wc * 32 + 8 * fq;
#pragma unroll
        for (int ai = 0; ai < 2; ++ai)
#pragma unroll
            for (int m = 0; m < 4; ++m) { bf16_t* rowp = base + (size_t)(row0 + ai * HALF + m * 16) * ld + col0;
#pragma unroll
                for (int bj = 0; bj < 2; ++bj) { const f32x4 v0 = acc[ai][bj][m][0], v1 = acc[ai][bj][m][1];
                    u32x4 w; w.x = pk_bf16(v0[0], v0[1]); w.y = pk_bf16(v0[2], v0[3]); w.z = pk_bf16(v1[0], v1[1]); w.w = pk_bf16(v1[2], v1[3]);
                    *(u32x4*)(rowp + bj * HALF) = w; } }
    }
};
template <int ACT> struct EpiPair {
    bf16_t* O; int ldc; int split_pn; bf16_t* O2; int ldc2;
    __device__ __forceinline__ void operator()(const Acc& acc, const Unit& u, int wr, int wc, int fr, int fq) const {
        const int row0 = u.pm * BM + wr * 64 + fr;
        if (u.pn >= split_pn) {
            const int col0 = (u.pn - split_pn) * BM + wc * 32 + 8 * fq;
#pragma unroll
            for (int ai = 0; ai < 2; ++ai)
#pragma unroll
                for (int m = 0; m < 4; ++m) { bf16_t* rowp = O2 + (size_t)(row0 + ai * HALF + m * 16) * ldc2 + col0;
#pragma unroll
                    for (int bj = 0; bj < 2; ++bj) { const f32x4 v0 = acc[ai][bj][m][0], v1 = acc[ai][bj][m][1];
                        u32x4 w; w.x = pk_bf16(v0[0], v0[1]); w.y = pk_bf16(v0[2], v0[3]); w.z = pk_bf16(v1[0], v1[1]); w.w = pk_bf16(v1[2], v1[3]);
                        *(u32x4*)(rowp + bj * HALF) = w; } }
            return;
        }
        const int col0 = u.pn * HALF + wc * 32 + 8 * fq;
#pragma unroll
        for (int ai = 0; ai < 2; ++ai)
#pragma unroll
            for (int m = 0; m < 4; ++m) { bf16_t* rowp = O + (size_t)(row0 + ai * HALF + m * 16) * ldc + col0;
                float r[8];
#pragma unroll
                for (int n = 0; n < 2; ++n)
#pragma unroll
                    for (int e = 0; e < 4; ++e) { const float p = acc[ai][0][m][n][e], q = acc[ai][1][m][n][e];
                        r[n * 4 + e] = (ACT == 0) ? p * sigmoidf_(p) * q : p * sigmoidf_(q); }
                u32x4 w; w.x = pk_bf16(r[0], r[1]); w.y = pk_bf16(r[2], r[3]); w.z = pk_bf16(r[4], r[5]); w.w = pk_bf16(r[6], r[7]);
                *(u32x4*)rowp = w; asm volatile("" ::: "memory"); }
    }
};
struct EpiResidual {
    const float* base; float* out; float scale;
    __device__ __forceinline__ void operator()(const Acc& acc, const Unit& u, int wr, int wc, int fr, int fq) const {
        const int row0 = u.pm * BM + wr * 64 + fr, col0 = u.pn * BM + wc * 32 + 8 * fq;
#pragma unroll
        for (int ai = 0; ai < 2; ++ai)
#pragma unroll
            for (int m = 0; m < 4; ++m) { const size_t off = (size_t)(row0 + ai * HALF + m * 16) * D_ + col0;
#pragma unroll
                for (int bj = 0; bj < 2; ++bj)
#pragma unroll
                    for (int n = 0; n < 2; ++n) { const f32x4 b = *(const f32x4*)(base + off + bj * HALF + 4 * n);
                        *(f32x4*)(out + off + bj * HALF + 4 * n) = b + acc[ai][bj][m][n] * scale; }
                asm volatile("" ::: "memory"); }
    }
};
struct EpiL1 {
    bf16_t* O;
    __device__ __forceinline__ void operator()(const Acc& acc, const Unit& u, int wr, int wc, int fr, int fq) const {
        const int row0 = u.pm * BM + wr * 64 + fr, col0 = wc * 32 + 8 * fq;
#pragma unroll
        for (int ai = 0; ai < 2; ++ai)
#pragma unroll
            for (int m = 0; m < 4; ++m) { bf16_t* rowp = O + (size_t)(row0 + ai * HALF + m * 16) * 256 + col0;
#pragma unroll
                for (int bj = 0; bj < 2; ++bj) { float r[8];
#pragma unroll
                    for (int n = 0; n < 2; ++n)
#pragma unroll
                        for (int e = 0; e < 4; ++e) { const float v = acc[ai][bj][m][n][e];
                            float o;
                            if (bj == 1) o = sigmoidf_(v);
                            else if (wc < 2) o = 1.0f - 2.0f * frcp(1.0f + fexp2(2.0f * LOG2E * v));
                            else o = v;
                            r[n * 4 + e] = o; }
                    u32x4 w; w.x = pk_bf16(r[0], r[1]); w.y = pk_bf16(r[2], r[3]); w.z = pk_bf16(r[4], r[5]); w.w = pk_bf16(r[6], r[7]);
                    *(u32x4*)(rowp + bj * HALF) = w; asm volatile("" ::: "memory"); } }
    }
};
struct EpiL2 {
    bf16_t* O; const float* w0; const float* a0;
    __device__ __forceinline__ void operator()(const Acc& acc, const Unit& u, int wr, int wc, int fr, int fq) const {
        const int row0 = u.pm * BM + wr * 64 + fr, col0 = u.pn * BM + wc * 32 + 8 * fq;
        const int kind = u.pn >> 2;
        const float* bias = kind == 1 ? a0 : w0;
        const float bsel = kind < 2 ? 1.f : 0.f, csc = kind == 0 ? 0.6065306597126334f : 1.f;
        const int bcol0 = (u.pn & 3) * BM + wc * 32 + 8 * fq;
#pragma unroll
        for (int bj = 0; bj < 2; ++bj) {
            const f32x4 b0 = *(const f32x4*)(bias + bcol0 + bj * HALF) * bsel, b1 = *(const f32x4*)(bias + bcol0 + bj * HALF + 4) * bsel;
#pragma unroll
            for (int ai = 0; ai < 2; ++ai)
#pragma unroll
                for (int m = 0; m < 4; ++m) { bf16_t* rowp = O + (size_t)(row0 + ai * HALF + m * 16) * 3072 + col0 + bj * HALF;
                    float r[8];
#pragma unroll
                    for (int e = 0; e < 4; ++e) { r[e] = acc[ai][bj][m][0][e] + b0[e]; r[4 + e] = acc[ai][bj][m][1][e] + b1[e]; }
#pragma unroll
                    for (int e = 0; e < 8; ++e) { const float sg = csc * sigmoidf_(r[e]); r[e] = kind == 2 ? r[e] : sg; }
                    u32x4 w; w.x = pk_f16(r[0], r[1]); w.y = pk_f16(r[2], r[3]); w.z = pk_f16(r[4], r[5]); w.w = pk_f16(r[6], r[7]);
                    *(u32x4*)rowp = w; asm volatile("" ::: "memory"); }
        }
    }
};

template <class Epi>
__device__ __forceinline__ void gemm_phase(LAS unsigned char* lds, const Gemm g, const StaticOrder& S, const Epi& E) {
    const int tid = threadIdx.x, wid = __builtin_amdgcn_readfirstlane(tid >> 6), lane = tid & 63, wr = wid >> 2, wc = wid & 3, fr = lane & 15, fq = lane >> 4;
    const int K = g.K, nt = K / BK;
    unsigned voffA[2], voffB[2];
#pragma unroll
    for (int i = 0; i < 2; ++i) { int R, C; stage_rc(tid * 16 + i * 8192, R, C); const int Rb = (R & ~31) + perm32(R & 31);
        voffA[i] = (unsigned)(R * g.lda + C) * 2u; voffB[i] = (unsigned)(Rb * g.ldb + C) * 2u; }
    const size_t kstep = (size_t)(BK * 2);
    const size_t hstepA = (size_t)HALF * g.lda * 2, hstepB = (size_t)HALF * g.ldb * 2;
    const size_t tstepA = 2 * hstepA, tstepB = 2 * hstepB;
    const unsigned ldsw = (unsigned)wid * 1024u;
    const int aoff = lds_byte(wr * 64 + fr, fq * 8), boff = lds_byte(wc * 32 + fr, fq * 8);
#define PG8_SA(b, h) (((b) * 2 + (h)) * HTB)
#define PG8_SB(b, h) ((4 + (b) * 2 + (h)) * HTB)
#define PG8_STAGE(bufoff, gbase, voff) do { _Pragma("unroll") for (int _i = 0; _i < 2; ++_i) \
        __builtin_amdgcn_global_load_lds((const unsigned*)((const char*)(gbase) + (voff)[_i]), (LAS unsigned*)(lds + (bufoff) + ldsw + _i * 8192), 16, 0, 0); } while (0)
#define PG8_LDA(dst, b, h) do { _Pragma("unroll") for (int m = 0; m < 4; ++m) _Pragma("unroll") for (int k = 0; k < 2; ++k) dst[m][k] = *(const LAS bf16x8*)(lds + PG8_SA(b, h) + aoff + m * 2048 + k * 1024); } while (0)
#define PG8_LDB(dst, b, h) do { _Pragma("unroll") for (int n = 0; n < 2; ++n) _Pragma("unroll") for (int k = 0; k < 2; ++k) dst[n][k] = *(const LAS bf16x8*)(lds + PG8_SB(b, h) + boff + n * 2048 + k * 1024); } while (0)
#define PG8_MMA(ai, bj, At, Bt) do { __builtin_amdgcn_s_setprio(1); _Pragma("unroll") for (int m = 0; m < 4; ++m) _Pragma("unroll") for (int n = 0; n < 2; ++n) _Pragma("unroll") for (int k = 0; k < 2; ++k) \
        acc[ai][bj][m][n] = __builtin_amdgcn_mfma_f32_16x16x32_bf16(Bt[n][k], At[m][k], acc[ai][bj][m][n], 0, 0, 0); __builtin_amdgcn_s_setprio(0); } while (0)
#define PG8_WAIT_V(n) asm volatile("s_waitcnt vmcnt(" #n ")" ::: "memory")
#define PG8_WAIT_L(n) asm volatile("s_waitcnt lgkmcnt(" #n ")" ::: "memory")
#define PG8_BAR __builtin_amdgcn_s_barrier()
#define PG8_SCHED __builtin_amdgcn_sched_barrier(0)
    Unit cur, nxt; int ui = 0;
    if (!S.next(0, cur)) return;
    Acc acc;
#pragma unroll
    for (int a = 0; a < 2; ++a)
#pragma unroll
        for (int b = 0; b < 2; ++b)
#pragma unroll
            for (int m = 0; m < 4; ++m)
#pragma unroll
                for (int n = 0; n < 2; ++n) acc[a][b][m][n] = (f32x4){0.f, 0.f, 0.f, 0.f};
    bf16x8 At[4][2], B0[2][2], B1[2][2];
    const char* cA = (const char*)g.A + (size_t)cur.pm * tstepA; const char* cB = (const char*)g.Bt + (size_t)cur.pn * tstepB;
    PG8_STAGE(PG8_SB(0, 0), cB, voffB); PG8_STAGE(PG8_SB(0, 1), cB + hstepB, voffB); PG8_STAGE(PG8_SA(0, 0), cA, voffA); PG8_STAGE(PG8_SA(0, 1), cA + hstepA, voffA);
    if (wr == 1) PG8_BAR;
    PG8_WAIT_V(2); PG8_BAR;
    PG8_STAGE(PG8_SB(1, 0), cB + kstep, voffB); PG8_STAGE(PG8_SA(1, 0), cA + kstep, voffA); PG8_STAGE(PG8_SB(1, 1), cB + hstepB + kstep, voffB);
    PG8_WAIT_V(6); PG8_BAR;
    for (;;) {
        const bool has_next = S.next(ui + 1, nxt);
        const char* nA = has_next ? (const char*)g.A + (size_t)nxt.pm * tstepA : cA; const char* nB = has_next ? (const char*)g.Bt + (size_t)nxt.pn * tstepB : cB;
        for (int t = 0; t < nt; t += 2) {
            const bool last = (t == nt - 2);
            const char* a1 = cA + (size_t)(t + 1) * kstep;
            const char* a2 = last ? nA : cA + (size_t)(t + 2) * kstep; const char* b2 = last ? nB : cB + (size_t)(t + 2) * kstep;
            const char* a3 = a2 + kstep; const char* b3 = b2 + kstep;
            PG8_LDB(B0, 0, 0); PG8_LDB(B1, 0, 1); PG8_SCHED; PG8_LDA(At, 0, 0); PG8_STAGE(PG8_SA(1, 1), a1 + hstepA, voffA);
            PG8_WAIT_V(8); PG8_WAIT_L(0); PG8_BAR; PG8_MMA(0, 0, At, B0); PG8_MMA(0, 1, At, B1); PG8_BAR; PG8_SCHED;
            PG8_LDA(At, 0, 1); PG8_STAGE(PG8_SB(0, 0), b2, voffB); PG8_STAGE(PG8_SB(0, 1), b2 + hstepB, voffB); PG8_STAGE(PG8_SA(0, 0), a2, voffA);
            PG8_WAIT_V(8); PG8_WAIT_L(0); PG8_BAR; PG8_MMA(1, 0, At, B0); PG8_MMA(1, 1, At, B1); PG8_BAR; PG8_SCHED;
            PG8_LDB(B0, 1, 0); PG8_LDB(B1, 1, 1); PG8_SCHED; PG8_LDA(At, 1, 0); PG8_STAGE(PG8_SA(0, 1), a2 + hstepA, voffA);
            PG8_WAIT_V(8); PG8_WAIT_L(0); PG8_BAR; PG8_MMA(0, 0, At, B0); PG8_MMA(0, 1, At, B1); PG8_BAR; PG8_SCHED;
            PG8_LDA(At, 1, 1); PG8_STAGE(PG8_SB(1, 0), b3, voffB); PG8_STAGE(PG8_SB(1, 1), b3 + hstepB, voffB); PG8_STAGE(PG8_SA(1, 0), a3, voffA);
            PG8_WAIT_V(8); PG8_WAIT_L(0); PG8_BAR; PG8_MMA(1, 0, At, B0); PG8_MMA(1, 1, At, B1); PG8_BAR; PG8_SCHED;
        }
        if (wr == 0) PG8_BAR;
        { int t2 = threadIdx.x; asm volatile("" : "+v"(t2)); const int l2 = t2 & 63; E(acc, cur, wr, wc, l2 & 15, l2 >> 4); }
        if (!has_next) break;
#pragma unroll
        for (int a = 0; a < 2; ++a)
#pragma unroll
            for (int b = 0; b < 2; ++b)
#pragma unroll
                for (int m = 0; m < 4; ++m)
#pragma unroll
                    for (int n = 0; n < 2; ++n) acc[a][b][m][n] = (f32x4){0.f, 0.f, 0.f, 0.f};
        cur = nxt; cA = nA; cB = nB; ++ui;
        if (wr == 1) PG8_BAR;
    }
    PG8_WAIT_V(0);
    PG8_BAR;
#undef PG8_SA
#undef PG8_SB
#undef PG8_STAGE
#undef PG8_LDA
#undef PG8_LDB
#undef PG8_MMA
#undef PG8_WAIT_V
#undef PG8_WAIT_L
#undef PG8_BAR
#undef PG8_SCHED
}
}

__device__ __forceinline__ void transpose_item(const Params& p, int jidx, int item, LAS float* scr, int lane) {
    const Job& jb = p.jobs[jidx];
    const float* src = jb.src; bf16_t* dst = jb.dst;
    const int ldsrc = jb.ldsrc, G = jb.G, lddst = jb.lddst, Nc = jb.Nc;
    const float scale = jb.scale;
    const int nblk = Nc / 32, kb = item / nblk, nb = item % nblk, k0 = 64 * kb, j0 = 32 * nb;
    const int grp = j0 / G, jin = j0 % G;
    const int srccol0 = jb.c0 + grp * jb.sstride + jin, dstrow0 = jb.r0 + grp * jb.dstride + jin;
    if (src) {
#pragma unroll 8
        for (int i = 0; i < 32; ++i) { const int kk = 2 * i + (lane >> 5); scr[kk * 33 + (lane & 31)] = src[(size_t)(k0 + kk) * ldsrc + srccol0 + (lane & 31)] * scale; }
    } else {
#pragma unroll 8
        for (int i = 0; i < 32; ++i) { const int kk = 2 * i + (lane >> 5); scr[kk * 33 + (lane & 31)] = 0.f; }
    }
    LDS_WAIT(); asm volatile("" ::: "memory");
    const int c = lane & 7;
#pragma unroll
    for (int j = 0; j < 4; ++j) { const int n = (lane >> 3) + 8 * j; const LAS float* s = scr + (8 * c) * 33 + n;
        u32x4 o; o.x = pk_bf16(s[0 * 33], s[1 * 33]); o.y = pk_bf16(s[2 * 33], s[3 * 33]); o.z = pk_bf16(s[4 * 33], s[5 * 33]); o.w = pk_bf16(s[6 * 33], s[7 * 33]);
        *(u32x4*)(dst + (size_t)(dstrow0 + n) * lddst + jb.dk0 + k0 + 8 * c) = o; }
    LDS_WAIT(); asm volatile("" ::: "memory");
}
__device__ __forceinline__ void weights_phase(const Params& p, LAS unsigned char* lds, int gw, int NGW, int wave, int lane) {
    LAS float* scr = (LAS float*)(lds + wave * 8704);
    for (int it = gw; it < p.nitems; it += NGW) {
        int j = 0;
        for (int q = 1; q < p.njobs; ++q) if (p.jobs[q].item0 <= it) j = q;
        j = __builtin_amdgcn_readfirstlane(j);
        transpose_item(p, j, it - p.jobs[j].item0, scr, lane);
    }
}

__device__ __forceinline__ void norm_phase(const float* x, const float* g, bf16_t* out, int gw, int NGW, int lane) {
    f32x4 gv[4];
#pragma unroll
    for (int j = 0; j < 4; ++j) gv[j] = *((const f32x4*)g + lane + 64 * j);
    for (int m = gw; m < T_; m += NGW) {
        const f32x4* xr = (const f32x4*)(x + (size_t)m * D_) + lane;
        f32x4 v[4]; float s = 0.f;
#pragma unroll
        for (int j = 0; j < 4; ++j) { v[j] = xr[64 * j]; s += (v[j].x * v[j].x + v[j].y * v[j].y) + (v[j].z * v[j].z + v[j].w * v[j].w); }
        const float rstd = 1.0f / sqrtf(wave_sum(s) * (1.f / D_) + 1e-6f);
        u32x2* o = (u32x2*)(out + (size_t)m * D_) + lane;
#pragma unroll
        for (int j = 0; j < 4; ++j) { const f32x4 y = v[j] * rstd * gv[j]; u32x2 w; w.x = pk_bf16(y.x, y.y); w.y = pk_bf16(y.z, y.w); o[64 * j] = w; }
    }
}
__device__ __forceinline__ void final_norm_phase(float* x, const float* g, int gw, int NGW, int lane) {
    f32x4 gv[4];
#pragma unroll
    for (int j = 0; j < 4; ++j) gv[j] = *((const f32x4*)g + lane + 64 * j);
    for (int m = gw; m < T_; m += NGW) {
        f32x4* xr = (f32x4*)(x + (size_t)m * D_) + lane;
        f32x4 v[4]; float s = 0.f;
#pragma unroll
        for (int j = 0; j < 4; ++j) { v[j] = xr[64 * j]; s += (v[j].x * v[j].x + v[j].y * v[j].y) + (v[j].z * v[j].z + v[j].w * v[j].w); }
        const float rstd = 1.0f / sqrtf(wave_sum(s) * (1.f / D_) + 1e-6f);
#pragma unroll
        for (int j = 0; j < 4; ++j) xr[64 * j] = v[j] * rstd * gv[j];
    }
}
__device__ __forceinline__ void mix_phase(const float* x, const float* g, const float* mu0, const float* mu1, const float* mu2, bf16_t* o0, size_t ostride, int ld, int gw, int NGW, int lane) {
    for (int m = gw; m < T_; m += NGW) {
        const int s_idx = m & (S_ - 1);
        const f32x4* xr = (const f32x4*)(x + (size_t)m * D_) + lane;
        f32x4 v[4], pv[4]; float s = 0.f, ps = 0.f;
#pragma unroll
        for (int j = 0; j < 4; ++j) { v[j] = xr[64 * j]; s += (v[j].x * v[j].x + v[j].y * v[j].y) + (v[j].z * v[j].z + v[j].w * v[j].w); }
        if (s_idx > 0) {
#pragma unroll
            for (int j = 0; j < 4; ++j) { pv[j] = xr[64 * j - 256]; ps += (pv[j].x * pv[j].x + pv[j].y * pv[j].y) + (pv[j].z * pv[j].z + pv[j].w * pv[j].w); }
        } else {
#pragma unroll
            for (int j = 0; j < 4; ++j) pv[j] = (f32x4){0.f, 0.f, 0.f, 0.f};
        }
        const float rstd = 1.0f / sqrtf(wave_sum(s) * (1.f / D_) + 1e-6f);
        const float prstd = 1.0f / sqrtf(wave_sum(ps) * (1.f / D_) + 1e-6f);
#pragma unroll
        for (int j = 0; j < 4; ++j) {
            const f32x4 gv = *((const f32x4*)g + lane + 64 * j);
            const f32x4 h = v[j] * rstd * gv, hh = pv[j] * prstd * gv - h;
            const f32x4 m0 = *((const f32x4*)mu0 + lane + 64 * j), m1 = *((const f32x4*)mu1 + lane + 64 * j), m2 = *((const f32x4*)mu2 + lane + 64 * j);
            const f32x4 y0 = h + hh * m0, y1 = h + hh * m1, y2 = h + hh * m2;
            u32x2 w;
            w.x = pk_bf16(y0.x, y0.y); w.y = pk_bf16(y0.z, y0.w); *((u32x2*)(o0 + (size_t)m * ld) + lane + 64 * j) = w;
            w.x = pk_bf16(y1.x, y1.y); w.y = pk_bf16(y1.z, y1.w); *((u32x2*)(o0 + ostride + (size_t)m * ld) + lane + 64 * j) = w;
            w.x = pk_bf16(y2.x, y2.y); w.y = pk_bf16(y2.z, y2.w); *((u32x2*)(o0 + 2 * ostride + (size_t)m * ld) + lane + 64 * j) = w;
        }
    }
}
__device__ __forceinline__ void latents_phase(bf16_t* ZL, const float* qn, const float* kvn, const int* pos, bf16_t* KPE, f32x2* ROPE, int gw, int NGW, int lane) {
    for (int m = gw; m < T_; m += NGW) {
        bf16_t* zr = ZL + (size_t)m * 1024;
        { u32x4 w = *((const u32x4*)zr + lane); float f[8] = {bf_lo(w.x), bf_hi(w.x), bf_lo(w.y), bf_hi(w.y), bf_lo(w.z), bf_hi(w.z), bf_lo(w.w), bf_hi(w.w)};
          float s = 0.f;
#pragma unroll
          for (int e = 0; e < 8; ++e) s += f[e] * f[e];
          const float rstd = 1.0f / sqrtf(wave_sum(s) * (1.f / 512.f) + 1e-6f);
          const f32x4 g0 = *((const f32x4*)qn + 2 * lane), g1 = *((const f32x4*)qn + 2 * lane + 1);
          u32x4 o; o.x = pk_bf16(f[0] * rstd * g0.x, f[1] * rstd * g0.y); o.y = pk_bf16(f[2] * rstd * g0.z, f[3] * rstd * g0.w);
          o.z = pk_bf16(f[4] * rstd * g1.x, f[5] * rstd * g1.y); o.w = pk_bf16(f[6] * rstd * g1.z, f[7] * rstd * g1.w);
          *((u32x4*)zr + lane) = o; }
        { u32x2 w = *((const u32x2*)(zr + 512) + lane); float f[4] = {bf_lo(w.x), bf_hi(w.x), bf_lo(w.y), bf_hi(w.y)};
          const float s = (f[0] * f[0] + f[1] * f[1]) + (f[2] * f[2] + f[3] * f[3]);
          const float rstd = 1.0f / sqrtf(wave_sum(s) * (1.f / 256.f) + 1e-6f);
          const f32x4 g0 = *((const f32x4*)kvn + lane);
          u32x2 o; o.x = pk_bf16(f[0] * rstd * g0.x, f[1] * rstd * g0.y); o.y = pk_bf16(f[2] * rstd * g0.z, f[3] * rstd * g0.w);
          *((u32x2*)(zr + 512) + lane) = o; }
        if (lane < 32) {
            const float invf = fexp2(-(float)lane * (13.287712379549449f / 32.0f));
            const float ang = (float)pos[m] * invf;
            const double rev = (double)ang * 0.15915494309189535;
            const float fr = (float)(rev - __builtin_rint(rev));
            const float cs = __builtin_amdgcn_cosf(fr), sn = __builtin_amdgcn_sinf(fr);
            ROPE[(size_t)m * 32 + lane] = (f32x2){cs, sn};
            const float x1 = __uint_as_float((unsigned)zr[768 + lane] << 16), x2 = __uint_as_float((unsigned)zr[800 + lane] << 16);
            const unsigned o1 = pk_bf16(x1 * cs - x2 * sn, 0.f), o2 = pk_bf16(x1 * sn + x2 * cs, 0.f);
            KPE[(size_t)m * 64 + lane] = (bf16_t)(o1 & 0xffffu); KPE[(size_t)m * 64 + 32 + lane] = (bf16_t)(o2 & 0xffffu);
        }
    }
}

__device__ __forceinline__ void conv_phase(LAS unsigned char* lds, const bf16_t* U, const float* cw, const float* cb, const float* lg, const float* lb, bf16_t* CONV, int vcu, int G) {
    const int tid = threadIdx.x, lane = tid & 63, wid = tid >> 6;
    LAS unsigned* ub = (LAS unsigned*)lds;
    LAS float* part = (LAS float*)(lds + 62 * 2048);
    LAS float* stat = part + 512;
    f32x2 W[31];
#pragma unroll
    for (int w = 0; w < 31; ++w) W[w] = *(const f32x2*)(cw + w * D_ + 2 * tid);
    const f32x2 bias = *(const f32x2*)(cb + 2 * tid), lgv = *(const f32x2*)(lg + 2 * tid), lbv = *(const f32x2*)(lb + 2 * tid);
    for (int item = vcu; item < NB_ * 64; item += G) {
        const int b = item >> 6, s0 = (item & 63) * 32;
        const size_t rowb = (size_t)b * S_;
        __syncthreads();
        for (int idx = tid; idx < 62 * 128; idx += 512) {
            const int r = idx >> 7, ch = idx & 127, s = s0 - 30 + r;
            u32x4 v = (u32x4){0u, 0u, 0u, 0u};
            if (s >= 0) v = *((const u32x4*)(U + (rowb + s) * D_) + ch);
            *((LAS u32x4*)(ub + r * 512) + ch) = v;
        }
        __syncthreads();
        f32x2 acc[32];
#pragma unroll
        for (int t = 0; t < 32; ++t) {
            f32x2 a = bias;
#pragma unroll
            for (int w = 0; w < 31; ++w) { const unsigned uu = ub[(t + w) * 512 + tid]; const f32x2 uv = {bf_lo(uu), bf_hi(uu)}; a += uv * W[w]; }
            acc[t] = a;
        }
#pragma unroll
        for (int t = 0; t < 32; ++t) {
            const float s1 = wave_sum(acc[t].x + acc[t].y), s2 = wave_sum(acc[t].x * acc[t].x + acc[t].y * acc[t].y);
            if (lane == 0) { part[(wid * 32 + t) * 2] = s1; part[(wid * 32 + t) * 2 + 1] = s2; }
        }
        __syncthreads();
        if (tid < 32) {
            float s1 = 0.f, s2 = 0.f;
#pragma unroll
            for (int w = 0; w < 8; ++w) { s1 += part[(w * 32 + tid) * 2]; s2 += part[(w * 32 + tid) * 2 + 1]; }
            const float mean = s1 * (1.f / D_), var = fmaxf(s2 * (1.f / D_) - mean * mean, 0.f);
            stat[tid * 2] = mean; stat[tid * 2 + 1] = 1.0f / sqrtf(var + 1e-5f);
        }
        __syncthreads();
#pragma unroll
        for (int t = 0; t < 32; ++t) {
            const float mean = stat[t * 2], rstd = stat[t * 2 + 1];
            const f32x2 hn = (acc[t] - mean) * rstd * lgv + lbv;
            const float o0 = hn.x * sigmoidf_(hn.x), o1 = hn.y * sigmoidf_(hn.y);
            *((unsigned*)(CONV + (rowb + s0 + t) * D_) + tid) = pk_bf16(o0, o1);
        }
    }
    __syncthreads();
}

namespace att {
constexpr int KP = 400, VP = 144, KT = 64 * KP, VT = 128 * VP, STG = KT + VT;
__device__ __forceinline__ void attn_unit(LAS unsigned char* lds, int b, int h, int qb, const bf16_t* Q, const bf16_t* KN, const bf16_t* KPE, const bf16_t* VTg, const f32x2* ROPE, bf16_t* ATT, const unsigned char* wsb) {
    const int tid = threadIdx.x, lane = tid & 63, r32 = lane & 31, hi = lane >> 5; const int wid = __builtin_amdgcn_readfirstlane(tid >> 6);
    const size_t rowb = (size_t)b * S_; const int q0 = qb * 256;
    const int NT = (q0 + 256) / 64;
    const char* gbase = (const char*)wsb;
    const unsigned kn_off = (unsigned)((const char*)(KN + (rowb + (tid >> 4)) * D_ + h * 128 + 8 * (tid & 15)) - gbase);
    const unsigned kp_off = (unsigned)((const char*)(KPE + (rowb + (tid >> 3)) * 64 + 8 * (tid & 7)) - gbase);
    const unsigned v_off = (unsigned)((const char*)(VTg + (size_t)(h * 128 + (tid >> 3)) * T_ + rowb + 8 * (tid & 7)) - gbase);
    const int kn_dst = (tid >> 4) * KP + (tid & 15) * 16, kp_dst = (tid >> 3) * KP + 256 + (tid & 7) * 16, v_dst = KT + (tid >> 3) * VP + (tid & 7) * 16;
    u32x4 kr[3], vr[2];
#define ATT_LOAD(t) do { kr[0] = *(const u32x4*)(gbase + (kn_off + (unsigned)(t) * (64u * D_ * 2u))); kr[1] = *(const u32x4*)(gbase + (kn_off + (unsigned)(t) * (64u * D_ * 2u) + 32u * D_ * 2u)); \
                         kr[2] = *(const u32x4*)(gbase + (kp_off + (unsigned)(t) * (64u * 64u * 2u))); \
                         vr[0] = *(const u32x4*)(gbase + (v_off + (unsigned)(t) * 128u)); vr[1] = *(const u32x4*)(gbase + (v_off + (unsigned)(t) * 128u + 64u * T_ * 2u)); } while (0)
#define ATT_STORE(st) do { *(LAS u32x4*)(lds + (st) * STG + kn_dst) = kr[0]; *(LAS u32x4*)(lds + (st) * STG + kn_dst + 32 * KP) = kr[1]; *(LAS u32x4*)(lds + (st) * STG + kp_dst) = kr[2]; \
                          *(LAS u32x4*)(lds + (st) * STG + v_dst) = vr[0]; *(LAS u32x4*)(lds + (st) * STG + v_dst + 64 * VP) = vr[1]; } while (0)
    ATT_LOAD(0);
    const size_t qrow = rowb + q0 + wid * 32 + r32;
    bf16x8 qf[12];
#pragma unroll
    for (int d0 = 0; d0 < 12; ++d0) qf[d0] = *(const bf16x8*)(Q + qrow * 1536 + h * 192 + d0 * 16 + hi * 8);
#pragma unroll
    for (int dd = 0; dd < 2; ++dd) {
        const f32x2* rp = ROPE + qrow * 32 + 16 * dd + 8 * hi;
        u32x4 a = __builtin_bit_cast(u32x4, qf[8 + dd]), c = __builtin_bit_cast(u32x4, qf[10 + dd]);
        unsigned ao[4], co[4];
#pragma unroll
        for (int w = 0; w < 4; ++w) {
            const f32x2 cs0 = rp[2 * w], cs1 = rp[2 * w + 1];
            const float x1a = bf_lo(a[w]), x1b = bf_hi(a[w]), x2a = bf_lo(c[w]), x2b = bf_hi(c[w]);
            ao[w] = pk_bf16(x1a * cs0.x - x2a * cs0.y, x1b * cs1.x - x2b * cs1.y);
            co[w] = pk_bf16(x1a * cs0.y + x2a * cs0.x, x1b * cs1.y + x2b * cs1.x);
        }
        qf[8 + dd] = __builtin_bit_cast(bf16x8, (u32x4){ao[0], ao[1], ao[2], ao[3]});
        qf[10 + dd] = __builtin_bit_cast(bf16x8, (u32x4){co[0], co[1], co[2], co[3]});
    }
    f32x16 o[4];
#pragma unroll
    for (int db = 0; db < 4; ++db)
#pragma unroll
        for (int r = 0; r < 16; ++r) o[db][r] = 0.f;
    float mrun = -1e30f, lrun = 0.f;
    const int kperm = 16 * ((r32 >> 2) & 1) + 4 * (r32 >> 3) + (r32 & 3);
    const int koff = kperm * KP + hi * 16;
    const int voff = KT + r32 * VP + hi * 32;
    const int qrel = wid * 32 + r32;
    ATT_STORE(0);
    __syncthreads();
    for (int t = 0; t < NT; ++t) {
        const int st = t & 1;
        if (t + 1 < NT) ATT_LOAD(t + 1);
        const int jb = t - (NT - 4);
        if (jb <= (wid >> 1)) {
            const LAS unsigned char* kb = lds + st * STG + koff;
            f32x16 p0, p1;
#pragma unroll
            for (int r = 0; r < 16; ++r) { p0[r] = 0.f; p1[r] = 0.f; }
#pragma unroll
            for (int d0 = 0; d0 < 12; ++d0) {
                const bf16x8 k0 = *(const LAS bf16x8*)(kb + d0 * 32), k1 = *(const LAS bf16x8*)(kb + 32 * KP + d0 * 32);
                p0 = __builtin_amdgcn_mfma_f32_32x32x16_bf16(k0, qf[d0], p0, 0, 0, 0);
                p1 = __builtin_amdgcn_mfma_f32_32x32x16_bf16(k1, qf[d0], p1, 0, 0, 0);
            }
            if (jb >= 0) {
                const int kv0 = 64 * jb + 16 * hi;
#pragma unroll
                for (int r = 0; r < 16; ++r) { if (kv0 + r > qrel) p0[r] = -INFINITY; if (kv0 + 32 + r > qrel) p1[r] = -INFINITY; }
            }
            float rm = fmaxf(p0[0], p1[0]);
#pragma unroll
            for (int r = 1; r < 16; ++r) rm = fmaxf(rm, fmaxf(p0[r], p1[r]));
            rm = fmaxf(rm, __shfl_xor(rm, 32));
            const float mnew = fmaxf(mrun, rm), alpha = fexp2(mrun - mnew);
            mrun = mnew;
            float ls = 0.f;
#pragma unroll
            for (int r = 0; r < 16; ++r) { p0[r] = fexp2(p0[r] - mnew); p1[r] = fexp2(p1[r] - mnew); ls += p0[r] + p1[r]; }
            lrun = lrun * alpha + ls;
#pragma unroll
            for (int db = 0; db < 4; ++db)
#pragma unroll
                for (int r = 0; r < 16; ++r) o[db][r] *= alpha;
            const LAS unsigned char* vb = lds + st * STG + voff;
#pragma unroll
            for (int gg = 0; gg < 2; ++gg)
#pragma unroll
                for (int j = 0; j < 2; ++j) {
                    u32x4 pw;
                    if (gg == 0) { pw.x = pk_bf16(p0[8 * j], p0[8 * j + 1]); pw.y = pk_bf16(p0[8 * j + 2], p0[8 * j + 3]); pw.z = pk_bf16(p0[8 * j + 4], p0[8 * j + 5]); pw.w = pk_bf16(p0[8 * j + 6], p0[8 * j + 7]); }
                    else         { pw.x = pk_bf16(p1[8 * j], p1[8 * j + 1]); pw.y = pk_bf16(p1[8 * j + 2], p1[8 * j + 3]); pw.z = pk_bf16(p1[8 * j + 4], p1[8 * j + 5]); pw.w = pk_bf16(p1[8 * j + 6], p1[8 * j + 7]); }
                    const bf16x8 pf = __builtin_bit_cast(bf16x8, pw);
#pragma unroll
                    for (int db = 0; db < 4; ++db) {
                        const bf16x8 vf = *(const LAS bf16x8*)(vb + db * 32 * VP + gg * 64 + j * 16);
                        o[db] = __builtin_amdgcn_mfma_f32_32x32x16_bf16(vf, pf, o[db], 0, 0, 0);
                    }
                }
        }
        if (t + 1 < NT) ATT_STORE(st ^ 1);
        __syncthreads();
    }
    const float ltot = lrun + __shfl_xor(lrun, 32);
    const float inv = 1.0f / ltot;
    bf16_t* orow = ATT + qrow * D_ + h * 128;
#pragma unroll
    for (int db = 0; db < 4; ++db)
#pragma unroll
        for (int rg = 0; rg < 4; ++rg) {
            u32x2 w; w.x = pk_bf16(o[db][4 * rg] * inv, o[db][4 * rg + 1] * inv); w.y = pk_bf16(o[db][4 * rg + 2] * inv, o[db][4 * rg + 3] * inv);
            *(u32x2*)(orow + 32 * db + 8 * rg + 4 * hi) = w;
        }
#undef ATT_LOAD
#undef ATT_STORE
}
}

namespace scan {
constexpr int CH = 32;
constexpr int O_NKK = 0, O_W = CH * 64, O_BV = 2 * CH * 64, O_KP = 3 * CH * 64, O_RR = 4 * CH * 64, O_VV = 5 * CH * 64, O_GG = 6 * CH * 64, O_BON = 7 * CH * 64, O_YB = 7 * CH * 64 + 64;
__device__ __forceinline__ float red8(float x) {
    x += __int_as_float(__builtin_amdgcn_update_dpp(0, __float_as_int(x), 0xB1, 0xF, 0xF, true));
    x += __int_as_float(__builtin_amdgcn_update_dpp(0, __float_as_int(x), 0x4E, 0xF, 0xF, true));
    x += __int_as_float(__builtin_amdgcn_update_dpp(0, __float_as_int(x), 0x141, 0xF, 0xF, true));
    return x;
}
__device__ __forceinline__ void scan_unit(LAS unsigned char* lds, int b, int h, const bf16_t* R, const bf16_t* K, const bf16_t* V, const bf16_t* WAG,
                                          const float* k_k, const float* k_a, const float* r_k, const float* ln_g, const float* ln_b, bf16_t* YG) {
    const int tid = threadIdx.x;
    LAS float* L = (LAS float*)lds;
    const int i = tid >> 3, c = tid & 7;
    const int ps = tid >> 4, pj = (tid & 15) * 4;
    const size_t rowb = (size_t)b * S_;
    const int hc = h * 64 + pj;
    const f32x4 kk4 = *(const f32x4*)(k_k + hc), ka4 = *(const f32x4*)(k_a + hc), rk4 = *(const f32x4*)(r_k + hc), lg4 = *(const f32x4*)(ln_g + hc), lb4 = *(const f32x4*)(ln_b + hc);
    f32x2 S2[4];
#pragma unroll
    for (int j = 0; j < 4; ++j) S2[j] = (f32x2){0.f, 0.f};
    u32x2 pr, pk, pvv, pe, pa, pg;
#define SCAN_LOAD(chk) do { const size_t tt = rowb + (size_t)(chk) * CH + ps; \
        pr = *(const u32x2*)(R + tt * D_ + hc); pk = *(const u32x2*)(K + tt * D_ + hc); pvv = *(const u32x2*)(V + tt * D_ + hc); \
        pe = *(const u32x2*)(WAG + tt * 3072 + hc); pa = *(const u32x2*)(WAG + tt * 3072 + 1024 + hc); pg = *(const u32x2*)(WAG + tt * 3072 + 2048 + hc); } while (0)
    SCAN_LOAD(0);
    for (int chk = 0; chk < S_ / CH; ++chk) {
        __syncthreads();
        {
            const f32x4 r4 = {bf_lo(pr.x), bf_hi(pr.x), bf_lo(pr.y), bf_hi(pr.y)}, k4 = {bf_lo(pk.x), bf_hi(pk.x), bf_lo(pk.y), bf_hi(pk.y)}, v4 = {bf_lo(pvv.x), bf_hi(pvv.x), bf_lo(pvv.y), bf_hi(pvv.y)};
            const f32x4 e4 = {h_lo(pe.x), h_hi(pe.x), h_lo(pe.y), h_hi(pe.y)}, a4 = {h_lo(pa.x), h_hi(pa.x), h_lo(pa.y), h_hi(pa.y)}, g4 = {h_lo(pg.x), h_hi(pg.x), h_lo(pg.y), h_hi(pg.y)};
            const f32x4 kkr = k4 * kk4;
            const float ss = sum16((kkr.x * kkr.x + kkr.y * kkr.y) + (kkr.z * kkr.z + kkr.w * kkr.w));
            const float inv = 1.0f / fmaxf(sqrtf(ss), 1e-12f);
            const f32x4 kk = kkr * inv;
            const f32x4 kp = k4 * (1.0f + (a4 - 1.0f) * ka4);
            f32x4 w; w.x = fexp2(-e4.x * LOG2E); w.y = fexp2(-e4.y * LOG2E); w.z = fexp2(-e4.z * LOG2E); w.w = fexp2(-e4.w * LOG2E);
            const f32x4 bv = kk * a4;
            const f32x4 bt = r4 * kp * rk4;
            const float bon = sum16((bt.x + bt.y) + (bt.z + bt.w));
            const int o = ps * 64 + pj;
            *(LAS f32x4*)(L + O_NKK + o) = -kk; *(LAS f32x4*)(L + O_W + o) = w; *(LAS f32x4*)(L + O_BV + o) = bv; *(LAS f32x4*)(L + O_KP + o) = kp;
            *(LAS f32x4*)(L + O_RR + o) = r4; *(LAS f32x4*)(L + O_VV + o) = v4; *(LAS f32x4*)(L + O_GG + o) = g4;
            if ((tid & 15) == 0) L[O_BON + ps] = bon;
        }
        __syncthreads();
        if (chk + 1 < S_ / CH) SCAN_LOAD(chk + 1);
#pragma unroll 2
        for (int s = 0; s < CH; ++s) {
            const int o = s * 64 + 8 * c;
            const f32x4 n0 = *(const LAS f32x4*)(L + O_NKK + o), n1 = *(const LAS f32x4*)(L + O_NKK + o + 4);
            const f32x4 w0 = *(const LAS f32x4*)(L + O_W + o), w1 = *(const LAS f32x4*)(L + O_W + o + 4);
            const f32x4 b0 = *(const LAS f32x4*)(L + O_BV + o), b1 = *(const LAS f32x4*)(L + O_BV + o + 4);
            const f32x4 q0 = *(const LAS f32x4*)(L + O_KP + o), q1 = *(const LAS f32x4*)(L + O_KP + o + 4);
            const f32x4 r0 = *(const LAS f32x4*)(L + O_RR + o), r1 = *(const LAS f32x4*)(L + O_RR + o + 4);
            const float vi = L[O_VV + s * 64 + i];
            f32x2 a2 = S2[0] * (f32x2){n0.x, n0.y};
            a2 += S2[1] * (f32x2){n0.z, n0.w}; a2 += S2[2] * (f32x2){n1.x, n1.y}; a2 += S2[3] * (f32x2){n1.z, n1.w};
            const float sa = red8(a2.x + a2.y);
            const f32x2 sa2 = {sa, sa}, vi2 = {vi, vi};
            S2[0] = S2[0] * (f32x2){w0.x, w0.y} + ((f32x2){b0.x, b0.y} * sa2 + (f32x2){q0.x, q0.y} * vi2);
            S2[1] = S2[1] * (f32x2){w0.z, w0.w} + ((f32x2){b0.z, b0.w} * sa2 + (f32x2){q0.z, q0.w} * vi2);
            S2[2] = S2[2] * (f32x2){w1.x, w1.y} + ((f32x2){b1.x, b1.y} * sa2 + (f32x2){q1.x, q1.y} * vi2);
            S2[3] = S2[3] * (f32x2){w1.z, w1.w} + ((f32x2){b1.z, b1.w} * sa2 + (f32x2){q1.z, q1.w} * vi2);
            f32x2 y2 = S2[0] * (f32x2){r0.x, r0.y};
            y2 += S2[1] * (f32x2){r0.z, r0.w}; y2 += S2[2] * (f32x2){r1.x, r1.y}; y2 += S2[3] * (f32x2){r1.z, r1.w};
            const float y = red8(y2.x + y2.y);
            if (c == 0) L[O_YB + s * 64 + i] = y;
        }
        __syncthreads();
        {
            const int o = ps * 64 + pj;
            const f32x4 y4 = *(const LAS f32x4*)(L + O_YB + o), v4 = *(const LAS f32x4*)(L + O_VV + o), g4 = *(const LAS f32x4*)(L + O_GG + o);
            const float bon = L[O_BON + ps];
            const float mu = sum16((y4.x + y4.y) + (y4.z + y4.w)) * (1.f / 64.f);
            const f32x4 d = y4 - mu;
            const float var = sum16((d.x * d.x + d.y * d.y) + (d.z * d.z + d.w * d.w)) * (1.f / 64.f);
            const float rstd = 1.0f / sqrtf(var + 64e-5f);
            const f32x4 out = (d * rstd * lg4 + lb4 + v4 * bon) * g4;
            u32x2 w; w.x = pk_bf16(out.x, out.y); w.y = pk_bf16(out.z, out.w);
            *(u32x2*)(YG + (rowb + (size_t)chk * CH + ps) * D_ + hc) = w;
        }
    }
    __syncthreads();
#undef SCAN_LOAD
}
}

#ifndef PHMASK
#define PHMASK 0xFFFF
#endif
#define EN(n) (((PHMASK) >> (n)) & 1)
constexpr int N_PHASES = 26;
__global__ void __launch_bounds__(512, 2) mega_fwd(Params p) {
    extern __shared__ __attribute__((aligned(16))) unsigned char smem[];
    LAS unsigned char* lds = (LAS unsigned char*)smem;
    __builtin_assume(__builtin_amdgcn_workitem_id_y() == 0); __builtin_assume(__builtin_amdgcn_workitem_id_z() == 0);
    cg::grid_group grid = cg::this_grid();
    const int tid = threadIdx.x, lane = tid & 63, wave = __builtin_amdgcn_readfirstlane(tid >> 6);
    const int G = gridDim.x, bx = blockIdx.x;
    const int vcu = (G % 8 == 0) ? (bx % 8) * (G / 8) + bx / 8 : bx;
    const int gw = vcu * 8 + wave, NGW = G * 8;
    unsigned char* ws = p.ws;
    float* X = p.out;
    bf16_t* XN = (bf16_t*)(ws + WS_XN);
    const int lo = p.ph_lo, hi = p.ph_hi;
    int ph = 0;
#define IN_PH() (lo <= ph && ph < hi)
#define END_PH() do { if (lo <= ph && ph + 1 < hi) grid.sync(); ++ph; } while (0)
#define GEMM_RUN(EpiT, Ev, Aop, Bop, M_, N_, K_, lda_, ldb_) do { pg8::Gemm g_{(const bf16_t*)(Aop), (const bf16_t*)(Bop), (M_), (N_), (K_), (lda_), (ldb_)}; pg8::StaticOrder S_o; S_o.init((M_), (N_), G, bx); \
        pg8::gemm_phase<EpiT>(lds, g_, S_o, Ev); } while (0)

    if (IN_PH()) { if (EN(0)) weights_phase(p, lds, gw, NGW, wave, lane); if (EN(1)) norm_phase(p.in[0], p.in[2], XN, gw, NGW, lane); }
    END_PH();
    {
            constexpr int f = 0;
            const bf16_t* Wgu = (const bf16_t*)(ws + WS_FFN + f * FFN_STRIDE); const bf16_t* Wdn = (const bf16_t*)(ws + WS_FFN + f * FFN_STRIDE + FFN_DN_OFF);
            if (f > 0) {
                if (IN_PH() && EN(1)) norm_phase(X, p.in[2] + f * D_, XN, gw, NGW, lane);
                END_PH();
            }
            if (IN_PH() && EN(2)) { pg8::EpiPair<0> E{(bf16_t*)(ws + WS_HID), FF_, 1 << 30, nullptr, 0}; GEMM_RUN(pg8::EpiPair<0>, E, XN, Wgu, T_, 2 * FF_, D_, D_, D_); }
            END_PH();
            if (IN_PH() && EN(3)) { pg8::EpiResidual E{f == 0 ? p.in[0] : X, X, 0.5f}; GEMM_RUN(pg8::EpiResidual, E, ws + WS_HID, Wdn, T_, D_, FF_, FF_, FF_); }
            END_PH();
    }
    {

                if (IN_PH() && EN(1)) norm_phase(X, p.in[6], XN, gw, NGW, lane);
                END_PH();
                if (IN_PH() && EN(4)) { pg8::EpiPair<1> E{(bf16_t*)(ws + WS_U), D_, 8, (bf16_t*)(ws + WS_ZL), 1024}; GEMM_RUN(pg8::EpiPair<1>, E, XN, ws + WS_WIN, T_, 3072, D_, D_, D_); }
                END_PH();
                if (IN_PH()) {
                    if (EN(5)) conv_phase(lds, (const bf16_t*)(ws + WS_U), p.in[8], p.in[9], p.in[10], p.in[11], (bf16_t*)(ws + WS_CONV), vcu, G);
                    if (EN(6)) latents_phase((bf16_t*)(ws + WS_ZL), p.in[12], p.in[14], (const int*)p.in[1], (bf16_t*)(ws + WS_KPE), (f32x2*)(ws + WS_ROPE), gw, NGW, lane);
                }
                END_PH();
                if (IN_PH() && EN(7)) {
                    { pg8::EpiStore E{(bf16_t*)(ws + WS_Q), 1536, 1 << 30, nullptr, 0}; GEMM_RUN(pg8::EpiStore, E, ws + WS_ZL, ws + WS_WUQ, T_, 1536, 512, 1024, 512); }
                    { pg8::EpiStore E{(bf16_t*)(ws + WS_KN), 1024, 1 << 30, nullptr, 0}; GEMM_RUN(pg8::EpiStore, E, ws + WS_ZL + 512 * 2, ws + WS_WKN, T_, 1024, 256, 1024, 256); }
                    { pg8::EpiStore E{(bf16_t*)(ws + WS_VT), T_, 1 << 30, nullptr, 0}; GEMM_RUN(pg8::EpiStore, E, ws + WS_WVT, ws + WS_ZL + 512 * 2, 1024, T_, 256, 256, 1024); }
                }
                END_PH();
                if (IN_PH() && EN(8)) {
                    for (int v = vcu; v < 256; v += G) {
                        const int bh = v >> 1, hf = v & 1;
#pragma unroll 1
                        for (int i = 0; i < 4; ++i) {
                            const int qb = hf == 0 ? (i == 0 ? 7 : i == 1 ? 0 : i == 2 ? 4 : 3) : (i == 0 ? 6 : i == 1 ? 1 : i == 2 ? 5 : 2);
                            att::attn_unit(lds, bh >> 3, bh & 7, qb, (const bf16_t*)(ws + WS_Q), (const bf16_t*)(ws + WS_KN), (const bf16_t*)(ws + WS_KPE), (const bf16_t*)(ws + WS_VT), (const f32x2*)(ws + WS_ROPE), (bf16_t*)(ws + WS_ATT), ws);
                        }
                    }
                }
                END_PH();
                if (IN_PH() && EN(3)) {
                    { pg8::EpiResidual E{X, X, 1.0f}; GEMM_RUN(pg8::EpiResidual, E, ws + WS_CONV, ws + WS_WOUT, T_, D_, 1024, 1024, 2048); }
                    { pg8::EpiResidual E{X, X, 1.0f}; GEMM_RUN(pg8::EpiResidual, E, ws + WS_ATT, ws + WS_WOUT + 1024 * 2, T_, D_, 1024, 1024, 2048); }
                }
                END_PH();
                }
    {
            constexpr int f = 1;
            const bf16_t* Wgu = (const bf16_t*)(ws + WS_FFN + f * FFN_STRIDE); const bf16_t* Wdn = (const bf16_t*)(ws + WS_FFN + f * FFN_STRIDE + FFN_DN_OFF);
            if (f > 0) {
                if (IN_PH() && EN(1)) norm_phase(X, p.in[2] + f * D_, XN, gw, NGW, lane);
                END_PH();
            }
            if (IN_PH() && EN(2)) { pg8::EpiPair<0> E{(bf16_t*)(ws + WS_HID), FF_, 1 << 30, nullptr, 0}; GEMM_RUN(pg8::EpiPair<0>, E, XN, Wgu, T_, 2 * FF_, D_, D_, D_); }
            END_PH();
            if (IN_PH() && EN(3)) { pg8::EpiResidual E{f == 0 ? p.in[0] : X, X, 0.5f}; GEMM_RUN(pg8::EpiResidual, E, ws + WS_HID, Wdn, T_, D_, FF_, FF_, FF_); }
            END_PH();
    }
    {
            constexpr int f = 2;
            const bf16_t* Wgu = (const bf16_t*)(ws + WS_FFN + f * FFN_STRIDE); const bf16_t* Wdn = (const bf16_t*)(ws + WS_FFN + f * FFN_STRIDE + FFN_DN_OFF);
            if (f > 0) {
                if (IN_PH() && EN(1)) norm_phase(X, p.in[2] + f * D_, XN, gw, NGW, lane);
                END_PH();
            }
            if (IN_PH() && EN(2)) { pg8::EpiPair<0> E{(bf16_t*)(ws + WS_HID), FF_, 1 << 30, nullptr, 0}; GEMM_RUN(pg8::EpiPair<0>, E, XN, Wgu, T_, 2 * FF_, D_, D_, D_); }
            END_PH();
            if (IN_PH() && EN(3)) { pg8::EpiResidual E{f == 0 ? p.in[0] : X, X, 0.5f}; GEMM_RUN(pg8::EpiResidual, E, ws + WS_HID, Wdn, T_, D_, FF_, FF_, FF_); }
            END_PH();
    }
    {

                const float* mu = p.in[18];
                if (IN_PH() && EN(9)) mix_phase(X, p.in[17], mu, mu + 2 * D_, mu + 3 * D_, (bf16_t*)(ws + WS_XR), (size_t)T_ * D_, D_, gw, NGW, lane);
                END_PH();
                if (IN_PH() && EN(7)) {
                    { pg8::EpiStore E{(bf16_t*)(ws + WS_R), D_, 1 << 30, nullptr, 0}; GEMM_RUN(pg8::EpiStore, E, ws + WS_XR, ws + WS_WR, T_, D_, D_, D_, D_); }
                    { pg8::EpiStore E{(bf16_t*)(ws + WS_K), D_, 1 << 30, nullptr, 0}; GEMM_RUN(pg8::EpiStore, E, ws + WS_XK, ws + WS_WK, T_, D_, D_, D_, D_); }
                    { pg8::EpiStore E{(bf16_t*)(ws + WS_V), D_, 1 << 30, nullptr, 0}; GEMM_RUN(pg8::EpiStore, E, ws + WS_XV, ws + WS_WV, T_, D_, D_, D_, D_); }
                }
                END_PH();
                if (IN_PH() && EN(9)) mix_phase(X, p.in[17], mu + 1 * D_, mu + 4 * D_, mu + 5 * D_, (bf16_t*)(ws + WS_XWAG), (size_t)D_, 3072, gw, NGW, lane);
                END_PH();
                if (IN_PH() && EN(10)) { pg8::EpiL1 E{(bf16_t*)(ws + WS_L1)}; GEMM_RUN(pg8::EpiL1, E, ws + WS_XWAG, ws + WS_WL1, T_, 256, 3072, 3072, 3072); }
                END_PH();
                if (IN_PH() && EN(11)) { pg8::EpiL2 E{(bf16_t*)(ws + WS_WAG), p.in[23], p.in[26]}; GEMM_RUN(pg8::EpiL2, E, ws + WS_L1, ws + WS_WL2, T_, 3072, 256, 256, 256); }
                END_PH();
                if (IN_PH() && EN(12)) {
                    for (int v = vcu; v < 256; v += G)
                        scan::scan_unit(lds, v >> 4, v & 15, (const bf16_t*)(ws + WS_R), (const bf16_t*)(ws + WS_K), (const bf16_t*)(ws + WS_V), (const bf16_t*)(ws + WS_WAG),
                                        p.in[31], p.in[32], p.in[33], p.in[34], p.in[35], (bf16_t*)(ws + WS_R));
                }
                END_PH();
                if (IN_PH() && EN(3)) { pg8::EpiResidual E{X, X, 1.0f}; GEMM_RUN(pg8::EpiResidual, E, ws + WS_R, ws + WS_WO, T_, D_, D_, D_, D_); }
                END_PH();
                }
    {
            constexpr int f = 3;
            const bf16_t* Wgu = (const bf16_t*)(ws + WS_FFN + f * FFN_STRIDE); const bf16_t* Wdn = (const bf16_t*)(ws + WS_FFN + f * FFN_STRIDE + FFN_DN_OFF);
            if (f > 0) {
                if (IN_PH() && EN(1)) norm_phase(X, p.in[2] + f * D_, XN, gw, NGW, lane);
                END_PH();
            }
            if (IN_PH() && EN(2)) { pg8::EpiPair<0> E{(bf16_t*)(ws + WS_HID), FF_, 1 << 30, nullptr, 0}; GEMM_RUN(pg8::EpiPair<0>, E, XN, Wgu, T_, 2 * FF_, D_, D_, D_); }
            END_PH();
            if (IN_PH() && EN(3)) { pg8::EpiResidual E{f == 0 ? p.in[0] : X, X, 0.5f}; GEMM_RUN(pg8::EpiResidual, E, ws + WS_HID, Wdn, T_, D_, FF_, FF_, FF_); }
            END_PH();
    }
    if (IN_PH() && EN(13)) final_norm_phase(X, p.in[36], gw, NGW, lane);
    END_PH();
}

static void add_job(Params& p, const float* src, bf16_t* dst, int ldsrc, int c0, int sstride, int G, int lddst, int r0, int dstride, int dk0, int Kc, int Nc, float scale) {
    if (p.njobs >= NJOBS) { fprintf(stderr, "too many jobs\n"); return; }
    Job& j = p.jobs[p.njobs++];
    j.src = src; j.dst = dst; j.ldsrc = ldsrc; j.c0 = c0; j.sstride = sstride; j.G = G; j.lddst = lddst; j.r0 = r0; j.dstride = dstride; j.dk0 = dk0; j.Kc = Kc; j.Nc = Nc; j.scale = scale;
    j.item0 = p.nitems; p.nitems += (Kc / 64) * (Nc / 32);
}

extern "C" void kernel_launch(void* const* d_in, const int* in_sizes, int n_in, void* d_out, int out_size, void* d_ws, size_t ws_size, hipStream_t stream) {
    static int grid = 0;
    if (grid == 0) {
        if (n_in != 37 || ws_size < WS_END) { fprintf(stderr, "kernel_launch: unexpected n_in %d / ws %zu\n", n_in, ws_size); grid = -1; return; }
        int dev = 0, cus = 0, per_cu = 0;
        (void)hipGetDevice(&dev); (void)hipDeviceGetAttribute(&cus, hipDeviceAttributeMultiprocessorCount, dev);
        if (hipFuncSetAttribute((const void*)mega_fwd, hipFuncAttributeMaxDynamicSharedMemorySize, LDS_BYTES) != hipSuccess) { fprintf(stderr, "hipFuncSetAttribute failed\n"); grid = -1; return; }
        if (hipOccupancyMaxActiveBlocksPerMultiprocessor(&per_cu, (const void*)mega_fwd, 512, LDS_BYTES) != hipSuccess || per_cu < 1) { fprintf(stderr, "occupancy query: %d\n", per_cu); per_cu = 1; }
        (void)hipGetLastError();
        grid = cus * 1;
        if (grid > 256) grid = 256;
    }
    if (grid < 0) return;
    Params p; memset(&p, 0, sizeof(p));
    for (int i = 0; i < 37; ++i) p.in[i] = (const float*)d_in[i];
    p.out = (float*)d_out; p.ws = (unsigned char*)d_ws;
    unsigned char* ws = (unsigned char*)d_ws;
    for (int f = 0; f < 4; ++f) {
        const float* wg = p.in[3] + (size_t)f * D_ * FF_; const float* wu = p.in[4] + (size_t)f * D_ * FF_; const float* wd = p.in[5] + (size_t)f * FF_ * D_;
        bf16_t* gu = (bf16_t*)(ws + WS_FFN + f * FFN_STRIDE); bf16_t* dn = (bf16_t*)(ws + WS_FFN + f * FFN_STRIDE + FFN_DN_OFF);
        add_job(p, wg, gu, FF_, 0, 128, 128, D_, 0, 256, 0, D_, FF_, 1.f);
        add_job(p, wu, gu, FF_, 0, 128, 128, D_, 128, 256, 0, D_, FF_, 1.f);
        add_job(p, wd, dn, D_, 0, 0, D_, FF_, 0, 0, 0, FF_, D_, 1.f);
    }
    { bf16_t* w = (bf16_t*)(ws + WS_WIN);
      add_job(p, p.in[7], w, 2880, 0, 128, 128, D_, 0, 256, 0, D_, 1024, 1.f);
      add_job(p, p.in[7], w, 2880, 1024, 128, 128, D_, 128, 256, 0, D_, 1024, 1.f);
      add_job(p, p.in[7], w, 2880, 2048, 0, 832, D_, 2048, 0, 0, D_, 832, 1.f);
      add_job(p, nullptr, w, 0, 0, 0, 192, D_, 2880, 0, 0, D_, 192, 1.f); }
    add_job(p, p.in[13], (bf16_t*)(ws + WS_WUQ), 1536, 0, 0, 1536, 512, 0, 0, 0, 512, 1536, 0.07216878364870322f * 1.4426950408889634f);
    add_job(p, p.in[15], (bf16_t*)(ws + WS_WKN), 2048, 0, 256, 128, 256, 0, 128, 0, 256, 1024, 1.f);
    add_job(p, p.in[15], (bf16_t*)(ws + WS_WVT), 2048, 128, 256, 128, 256, 0, 128, 0, 256, 1024, 1.f);
    add_job(p, p.in[16], (bf16_t*)(ws + WS_WOUT), 1024, 0, 0, 1024, 2048, 0, 0, 0, 2048, 1024, 1.f);
    add_job(p, p.in[19], (bf16_t*)(ws + WS_WR), 1024, 0, 0, 1024, 1024, 0, 0, 0, 1024, 1024, 1.f);
    add_job(p, p.in[20], (bf16_t*)(ws + WS_WK), 1024, 0, 0, 1024, 1024, 0, 0, 0, 1024, 1024, 1.f);
    add_job(p, p.in[21], (bf16_t*)(ws + WS_WV), 1024, 0, 0, 1024, 1024, 0, 0, 0, 1024, 1024, 1.f);
    add_job(p, p.in[22], (bf16_t*)(ws + WS_WO), 1024, 0, 0, 1024, 1024, 0, 0, 0, 1024, 1024, 1.f);
    { bf16_t* w = (bf16_t*)(ws + WS_WL1);
      add_job(p, p.in[24], w, 64, 0, 0, 64, 3072, 0, 0, 0, 1024, 64, 1.f);
      add_job(p, p.in[27], w, 64, 0, 0, 64, 3072, 64, 0, 1024, 1024, 64, 1.f);
      add_job(p, p.in[29], w, 128, 0, 0, 128, 3072, 128, 0, 2048, 1024, 128, 1.f);
      add_job(p, nullptr, w, 0, 0, 0, 64, 3072, 0, 0, 1024, 2048, 64, 1.f);
      add_job(p, nullptr, w, 0, 0, 0, 64, 3072, 64, 0, 0, 1024, 64, 1.f);
      add_job(p, nullptr, w, 0, 0, 0, 64, 3072, 64, 0, 2048, 1024, 64, 1.f);
      add_job(p, nullptr, w, 0, 0, 0, 128, 3072, 128, 0, 0, 2048, 128, 1.f); }
    { bf16_t* w = (bf16_t*)(ws + WS_WL2);
      add_job(p, p.in[25], w, 1024, 0, 0, 1024, 256, 0, 0, 0, 64, 1024, 1.f);
      add_job(p, p.in[28], w, 1024, 0, 0, 1024, 256, 1024, 0, 64, 64, 1024, 1.f);
      add_job(p, p.in[30], w, 1024, 0, 0, 1024, 256, 2048, 0, 128, 128, 1024, 1.f);
      add_job(p, nullptr, w, 0, 0, 0, 1024, 256, 0, 0, 64, 192, 1024, 1.f);
      add_job(p, nullptr, w, 0, 0, 0, 1024, 256, 1024, 0, 0, 64, 1024, 1.f);
      add_job(p, nullptr, w, 0, 0, 0, 1024, 256, 1024, 0, 128, 128, 1024, 1.f);
      add_job(p, nullptr, w, 0, 0, 0, 1024, 256, 2048, 0, 0, 128, 1024, 1.f); }
    p.ph_lo = 0; p.ph_hi = N_PHASES;
    void* args[] = {&p};
    hipError_t e = hipLaunchCooperativeKernel((const void*)mega_fwd, dim3(grid), dim3(512), args, LDS_BYTES, stream);
    if (e != hipSuccess) fprintf(stderr, "cooperative launch failed: %s (grid %d)\n", hipGetErrorString(e), grid);
}
```

```cpp
#include <hip/hip_runtime.h>
#include <hip/hip_cooperative_groups.h>
#include <cstdio>
#include <cstdint>
#include <cstring>
namespace cg = cooperative_groups;

#define LAS __attribute__((address_space(3)))
typedef unsigned short bf16_t;
typedef short bf16x8 __attribute__((ext_vector_type(8)));
typedef float f32x4 __attribute__((ext_vector_type(4)));
typedef float f32x2 __attribute__((ext_vector_type(2)));
typedef float f32x16 __attribute__((ext_vector_type(16)));
typedef unsigned u32x4 __attribute__((ext_vector_type(4)));
typedef unsigned u32x2 __attribute__((ext_vector_type(2)));

constexpr int T_ = 32768, D_ = 1024, FF_ = 2816, S_ = 2048, NB_ = 16;
constexpr float LOG2E = 1.4426950408889634f;
constexpr size_t MiB = 1u << 20;
constexpr size_t WS_FFN = 0;
constexpr size_t FFN_STRIDE = 16 * MiB + MiB / 2, FFN_DN_OFF = 11 * MiB;
constexpr size_t WS_WIN = 66 * MiB, WS_WUQ = 72 * MiB, WS_WKN = 73 * MiB + MiB / 2, WS_WVT = 74 * MiB, WS_WOUT = 74 * MiB + MiB / 2;
constexpr size_t WS_WR = 78 * MiB + MiB / 2, WS_WK = 80 * MiB + MiB / 2, WS_WV = 82 * MiB + MiB / 2, WS_WO = 84 * MiB + MiB / 2;
constexpr size_t WS_WL1 = 86 * MiB + MiB / 2, WS_WL2 = 88 * MiB;
constexpr size_t WS_XN = 96 * MiB;
constexpr size_t WS_VT = 96 * MiB;
constexpr size_t WS_HID = 160 * MiB;
constexpr size_t WS_U = 160 * MiB;
constexpr size_t WS_Q = 160 * MiB;
constexpr size_t WS_ZL = 288 * MiB;
constexpr size_t WS_ATT = 288 * MiB;
constexpr size_t WS_CONV = 352 * MiB;
constexpr size_t WS_KN = 416 * MiB;
constexpr size_t WS_KPE = 480 * MiB;
constexpr size_t WS_ROPE = 484 * MiB;
constexpr size_t WS_R = 96 * MiB, WS_K = 160 * MiB, WS_V = 224 * MiB;
constexpr size_t WS_XR = 288 * MiB, WS_XK = 352 * MiB, WS_XV = 416 * MiB;
constexpr size_t WS_XWAG = 288 * MiB;
constexpr size_t WS_WAG = 288 * MiB;
constexpr size_t WS_L1 = 480 * MiB;
constexpr size_t WS_XB3 = 336 * MiB;
constexpr size_t WS_SS = 502 * MiB;
constexpr size_t WS_END = 512 * MiB;

constexpr int LDS_BYTES = 147456;
constexpr int NJOBS = 40;

struct Job { const float* src; bf16_t* dst; const float* kscale; int ldsrc, c0, sstride, G, lddst, r0, dstride, dk0, Kc, Nc, item0; float scale; };
struct Params {
    const float* in[37];
    float* out; unsigned char* ws;
    int njobs, nitems, ph_lo, ph_hi;
    Job jobs[NJOBS];
};

__device__ __forceinline__ unsigned pk_bf16(float lo, float hi) { typedef __bf16 b2 __attribute__((ext_vector_type(2))); f32x2 v = {lo, hi}; b2 b = __builtin_convertvector(v, b2); return __builtin_bit_cast(unsigned, b); }
__device__ __forceinline__ unsigned pk_f16(float lo, float hi) { typedef _Float16 h2 __attribute__((ext_vector_type(2))); h2 b = {(_Float16)lo, (_Float16)hi}; return __builtin_bit_cast(unsigned, b); }
__device__ __forceinline__ float bf_lo(unsigned u) { return __uint_as_float(u << 16); }
__device__ __forceinline__ float bf_hi(unsigned u) { return __uint_as_float(u & 0xffff0000u); }
__device__ __forceinline__ float h_lo(unsigned u) { typedef _Float16 h2 __attribute__((ext_vector_type(2))); h2 b = __builtin_bit_cast(h2, u); return (float)b[0]; }
__device__ __forceinline__ float h_hi(unsigned u) { typedef _Float16 h2 __attribute__((ext_vector_type(2))); h2 b = __builtin_bit_cast(h2, u); return (float)b[1]; }
__device__ __forceinline__ float fexp2(float x) { return __builtin_amdgcn_exp2f(x); }
__device__ __forceinline__ float frcp(float x) { return __builtin_amdgcn_rcpf(x); }
__device__ __forceinline__ float sigmoidf_(float x) { return frcp(1.0f + fexp2(-x * LOG2E)); }
__device__ __forceinline__ float wave_sum(float v) {
#pragma unroll
    for (int o = 1; o < 64; o <<= 1) v += __shfl_xor(v, o);
    return v;
}
__device__ __forceinline__ float sum16(float v) {
#pragma unroll
    for (int o = 1; o < 16; o <<= 1) v += __shfl_xor(v, o);
    return v;
}
#define LDS_WAIT() asm volatile("s_waitcnt lgkmcnt(0)" ::: "memory")

namespace pg8 {
constexpr int BM = 256, BK = 64, HALF = 128, HTB = HALF * BK * 2, STAGE_BYTES = 8 * HTB, NXCD = 8, WGM = 8;
__host__ __device__ __forceinline__ int lds_byte(int r, int c) { const int st = (r >> 4) * 2 + (c >> 5), rr = r & 15, cc = c & 31, ob = rr * 64 + cc * 2; return st * 1024 + (ob ^ (((ob >> 9) & 1) << 5)); }
__host__ __device__ __forceinline__ void stage_rc(int b, int& R, int& C) { const int st = b / 1024, sb = b % 1024, swz = sb ^ (((sb >> 9) & 1) << 5); R = (st >> 1) * 16 + swz / 64; C = (st & 1) * 32 + (swz % 64) / 2; }
__host__ __device__ __forceinline__ int perm32(int rho) { const int n = rho >> 4, i = rho & 15; return 8 * (i >> 2) + 4 * n + (i & 3); }

struct Unit { int pm, pn; };
struct Gemm { const bf16_t* A; const bf16_t* Bt; int M, N, K, lda, ldb; const bf16_t* A2; int ksp; };

struct StaticOrder {
    int nM, nN, nwg, G, c;
    __device__ void init(int M, int N, int G_, int c_) { nM = M / BM; nN = N / BM; nwg = nM * nN; G = G_; c = c_; }
    __device__ bool next(int i, Unit& u) const {
        const long L = (long)i * G + c; if (L >= nwg) return false;
        int wgid = (int)L; { const int q = nwg / NXCD, r = nwg % NXCD, xcd = wgid % NXCD, off = wgid / NXCD; wgid = (xcd < r ? xcd * (q + 1) : r * (q + 1) + (xcd - r) * q) + off; }
        const int nig = WGM * nN, gid = wgid / nig, fm = gid * WGM, gsz = (nM - fm) < WGM ? (nM - fm) : WGM;
        u.pm = fm + ((wgid % nig) % gsz); u.pn = (wgid % nig) / gsz; return true;
    }
};

typedef f32x4 Acc[2][2][4][2];

template <int MODE> struct EpiStoreT {
    bf16_t* O; int ldc;
    __device__ __forceinline__ void operator()(const Acc& acc, const Unit& u, int wr, int wc, int fr, int fq) const {
        const int row0 = u.pm * BM + wr * 64 + fr, col0 = u.pn * BM + wc * 32 + 8 * fq;
#pragma unroll
        for (int ai = 0; ai < 2; ++ai)
#pragma unroll
            for (int m = 0; m < 4; ++m) { const int row = row0 + ai * HALF + m * 16;
#pragma unroll
                for (int bj = 0; bj < 2; ++bj) { const int col = col0 + bj * HALF; size_t idx;
                    if (MODE == 0) idx = (size_t)row * ldc + col;
                    else if (MODE == 1) idx = ((size_t)((row >> 11) * 8 + (col >> 7)) * 2048 + (row & 2047)) * 128 + (col & 127);
                    else idx = ((((size_t)((col >> 11) * 8 + (row >> 7))) * 32 + ((col & 2047) >> 6)) * 128 + (row & 127)) * 64 + (col & 63);
                    const f32x4 v0 = acc[ai][bj][m][0], v1 = acc[ai][bj][m][1];
                    u32x4 w; w.x = pk_bf16(v0[0], v0[1]); w.y = pk_bf16(v0[2], v0[3]); w.z = pk_bf16(v1[0], v1[1]); w.w = pk_bf16(v1[2], v1[3]);
                    *(u32x4*)(O + idx) = w; } }
    }
};
typedef EpiStoreT<0> EpiStore;
__device__ __forceinline__ float row_rstd(const float* ss, int row) {
    if (!ss) return 1.0f;
    const f32x4* q = (const f32x4*)(ss + (size_t)row * 16);
    const f32x4 a = q[0], b = q[1], c = q[2], d = q[3];
    const float t = ((a.x + a.y) + (a.z + a.w)) + ((b.x + b.y) + (b.z + b.w)) + ((c.x + c.y) + (c.z + c.w)) + ((d.x + d.y) + (d.z + d.w));
    return 1.0f / sqrtf(t * (1.f / D_) + 1e-6f);
}
template <int ACT> struct EpiPair {
    bf16_t* O; int ldc; int split_pn; bf16_t* O2; int ldc2; const float* ss; LAS float* tab;
    __device__ __forceinline__ void operator()(const Acc& acc, const Unit& u, int wr, int wc, int fr, int fq) const {
        const int row0 = u.pm * BM + wr * 64 + fr;
        if (ss) {
            int t2 = threadIdx.x; asm volatile("" : "+v"(t2));
            const f32x4* q = (const f32x4*)(ss + ((size_t)(u.pm * BM + (t2 >> 1)) * 16 + (t2 & 1) * 8));
            const f32x4 a = q[0], b = q[1];
            float t = ((a.x + a.y) + (a.z + a.w)) + ((b.x + b.y) + (b.z + b.w));
            t += __shfl_xor(t, 1);
            if ((t2 & 1) == 0) tab[t2 >> 1] = 1.0f / sqrtf(t * (1.f / D_) + 1e-6f);
            asm volatile("s_waitcnt lgkmcnt(0)" ::: "memory"); __builtin_amdgcn_s_barrier(); asm volatile("" ::: "memory");
        }
        const int trow0 = wr * 64 + fr;
        if (u.pn >= split_pn) {
            const int col0 = (u.pn - split_pn) * BM + wc * 32 + 8 * fq;
#pragma unroll
            for (int ai = 0; ai < 2; ++ai)
#pragma unroll
                for (int m = 0; m < 4; ++m) { const int row = row0 + ai * HALF + m * 16; bf16_t* rowp = O2 + (size_t)row * ldc2 + col0;
                    const float rs = ss ? tab[trow0 + ai * HALF + m * 16] : 1.0f;
#pragma unroll
                    for (int bj = 0; bj < 2; ++bj) { const f32x4 v0 = acc[ai][bj][m][0] * rs, v1 = acc[ai][bj][m][1] * rs;
                        u32x4 w; w.x = pk_bf16(v0[0], v0[1]); w.y = pk_bf16(v0[2], v0[3]); w.z = pk_bf16(v1[0], v1[1]); w.w = pk_bf16(v1[2], v1[3]);
                        *(u32x4*)(rowp + bj * HALF) = w; }
                    asm volatile("" ::: "memory"); }
            return;
        }
        const int col0 = u.pn * HALF + wc * 32 + 8 * fq;
#pragma unroll
        for (int ai = 0; ai < 2; ++ai)
#pragma unroll
            for (int m = 0; m < 4; ++m) { const int row = row0 + ai * HALF + m * 16; bf16_t* rowp = O + (size_t)row * ldc + col0;
                const float rs = ss ? tab[trow0 + ai * HALF + m * 16] : 1.0f;
                float r[8];
#pragma unroll
                for (int n = 0; n < 2; ++n)
#pragma unroll
                    for (int e = 0; e < 4; ++e) { const float p = acc[ai][0][m][n][e] * rs, q = acc[ai][1][m][n][e] * rs;
                        r[n * 4 + e] = (ACT == 0) ? p * sigmoidf_(p) * q : p * sigmoidf_(q); }
                u32x4 w; w.x = pk_bf16(r[0], r[1]); w.y = pk_bf16(r[2], r[3]); w.z = pk_bf16(r[4], r[5]); w.w = pk_bf16(r[6], r[7]);
                *(u32x4*)rowp = w; asm volatile("" ::: "memory"); }
    }
};
template <bool BASE_F32, bool STATS> struct EpiRes {
    const void* base; bf16_t* out; float scale; float* ss;
    __device__ __forceinline__ void operator()(const Acc& acc, const Unit& u, int wr, int wc, int fr, int fq) const {
        const int row0 = u.pm * BM + wr * 64 + fr, col0 = u.pn * BM + wc * 32 + 8 * fq;
        u32x4 cb0, cb1;
        if (!BASE_F32) { const bf16_t* bp = (const bf16_t*)base + (size_t)row0 * D_ + col0; cb0 = *(const u32x4*)bp; cb1 = *(const u32x4*)(bp + HALF); }
#pragma unroll
        for (int it = 0; it < 8; ++it) { const int ai = it >> 2, m = it & 3;
            const int row = row0 + ai * HALF + m * 16; const size_t off = (size_t)row * D_ + col0;
            u32x4 nb0, nb1;
            if (!BASE_F32 && it < 7) { const int nrow = row0 + ((it + 1) >> 2) * HALF + ((it + 1) & 3) * 16; const bf16_t* bp = (const bf16_t*)base + (size_t)nrow * D_ + col0; nb0 = *(const u32x4*)bp; nb1 = *(const u32x4*)(bp + HALF); }
            float sq = 0.f;
#pragma unroll
            for (int bj = 0; bj < 2; ++bj) {
                f32x4 b0, b1;
                if (BASE_F32) { b0 = *(const f32x4*)((const float*)base + off + bj * HALF); b1 = *(const f32x4*)((const float*)base + off + bj * HALF + 4); }
                else { const u32x4 cb = bj == 0 ? cb0 : cb1; b0 = (f32x4){bf_lo(cb.x), bf_hi(cb.x), bf_lo(cb.y), bf_hi(cb.y)}; b1 = (f32x4){bf_lo(cb.z), bf_hi(cb.z), bf_lo(cb.w), bf_hi(cb.w)}; }
                const f32x4 o0 = b0 + acc[ai][bj][m][0] * scale, o1 = b1 + acc[ai][bj][m][1] * scale;
                if (STATS) sq += (o0[0] * o0[0] + o0[1] * o0[1]) + (o0[2] * o0[2] + o0[3] * o0[3]) + (o1[0] * o1[0] + o1[1] * o1[1]) + (o1[2] * o1[2] + o1[3] * o1[3]);
                u32x4 w; w.x = pk_bf16(o0[0], o0[1]); w.y = pk_bf16(o0[2], o0[3]); w.z = pk_bf16(o1[0], o1[1]); w.w = pk_bf16(o1[2], o1[3]);
                *(u32x4*)(out + off + bj * HALF) = w; }
            if (STATS) { sq += __shfl_xor(sq, 16); sq += __shfl_xor(sq, 32);
                if (fq == 0) ss[(size_t)row * 16 + u.pn * 4 + wc] = sq; }
            asm volatile("" ::: "memory");
            if (!BASE_F32) { cb0 = nb0; cb1 = nb1; } }
    }
};
struct EpiL1 {
    bf16_t* O;
    __device__ __forceinline__ void operator()(const Acc& acc, const Unit& u, int wr, int wc, int fr, int fq) const {
        const int blk = u.pm >> 7;
        const int row0 = (u.pm & 127) * BM + wr * 64 + fr, col0 = wc * 32 + 8 * fq;
        if (blk == 2) {
#pragma unroll
            for (int ai = 0; ai < 2; ++ai)
#pragma unroll
                for (int m = 0; m < 4; ++m) { bf16_t* rowp = O + (size_t)(row0 + ai * HALF + m * 16) * 256 + col0 + HALF; float r[8];
#pragma unroll
                    for (int n = 0; n < 2; ++n)
#pragma unroll
                        for (int e = 0; e < 4; ++e) r[n * 4 + e] = sigmoidf_(acc[ai][1][m][n][e]);
                    u32x4 w; w.x = pk_bf16(r[0], r[1]); w.y = pk_bf16(r[2], r[3]); w.z = pk_bf16(r[4], r[5]); w.w = pk_bf16(r[6], r[7]);
                    *(u32x4*)rowp = w; asm volatile("" ::: "memory"); }
        } else if ((wc >> 1) == blk) {
#pragma unroll
            for (int ai = 0; ai < 2; ++ai)
#pragma unroll
                for (int m = 0; m < 4; ++m) { bf16_t* rowp = O + (size_t)(row0 + ai * HALF + m * 16) * 256 + col0; float r[8];
#pragma unroll
                    for (int n = 0; n < 2; ++n)
#pragma unroll
                        for (int e = 0; e < 4; ++e) { const float v = acc[ai][0][m][n][e];
                            r[n * 4 + e] = blk == 0 ? 1.0f - 2.0f * frcp(1.0f + fexp2(2.0f * LOG2E * v)) : v; }
                    u32x4 w; w.x = pk_bf16(r[0], r[1]); w.y = pk_bf16(r[2], r[3]); w.z = pk_bf16(r[4], r[5]); w.w = pk_bf16(r[6], r[7]);
                    *(u32x4*)rowp = w; asm volatile("" ::: "memory"); }
        }
    }
};
struct EpiL2 {
    bf16_t* O; const float* w0; const float* a0;
    __device__ __forceinline__ void operator()(const Acc& acc, const Unit& u, int wr, int wc, int fr, int fq) const {
        const int row0 = u.pm * BM + wr * 64 + fr, col0 = u.pn * BM + wc * 32 + 8 * fq;
        const int kind = u.pn >> 2;
        const float* bias = kind == 1 ? a0 : w0;
        const float bsel = kind < 2 ? 1.f : 0.f, csc = kind == 0 ? 0.6065306597126334f : 1.f;
        const int bcol0 = (u.pn & 3) * BM + wc * 32 + 8 * fq;
#pragma unroll
        for (int bj = 0; bj < 2; ++bj) {
            const f32x4 b0 = *(const f32x4*)(bias + bcol0 + bj * HALF) * bsel, b1 = *(const f32x4*)(bias + bcol0 + bj * HALF + 4) * bsel;
#pragma unroll
            for (int ai = 0; ai < 2; ++ai)
#pragma unroll
                for (int m = 0; m < 4; ++m) { bf16_t* rowp = O + (size_t)(row0 + ai * HALF + m * 16) * 3072 + col0 + bj * HALF;
                    float r[8];
#pragma unroll
                    for (int e = 0; e < 4; ++e) { r[e] = acc[ai][bj][m][0][e] + b0[e]; r[4 + e] = acc[ai][bj][m][1][e] + b1[e]; }
#pragma unroll
                    for (int e = 0; e < 8; ++e) { const float sg = csc * sigmoidf_(r[e]); r[e] = kind == 2 ? r[e] : sg; }
                    u32x4 w; w.x = pk_f16(r[0], r[1]); w.y = pk_f16(r[2], r[3]); w.z = pk_f16(r[4], r[5]); w.w = pk_f16(r[6], r[7]);
                    *(u32x4*)rowp = w; asm volatile("" ::: "memory"); }
        }
    }
};

template <class Epi>
__device__ __forceinline__ void gemm_phase(LAS unsigned char* lds, const Gemm g, const StaticOrder& S, const Epi& E) {
    const int tid = threadIdx.x, wid = __builtin_amdgcn_readfirstlane(tid >> 6), lane = tid & 63, wr = wid >> 2, wc = wid & 3, fr = lane & 15, fq = lane >> 4;
    const int K = g.K, nt = K / BK;
    unsigned voffA[2], voffB[2];
#pragma unroll
    for (int i = 0; i < 2; ++i) { int R, C; stage_rc(tid * 16 + i * 8192, R, C); const int Rb = (R & ~31) + perm32(R & 31);
        voffA[i] = (unsigned)(R * g.lda + C) * 2u; voffB[i] = (unsigned)(Rb * g.ldb + C) * 2u; }
    const size_t kstep = (size_t)(BK * 2);
    const size_t hstepA = (size_t)HALF * g.lda * 2, hstepB = (size_t)HALF * g.ldb * 2;
    const size_t tstepA = 2 * hstepA, tstepB = 2 * hstepB;
    const unsigned ldsw = (unsigned)wid * 1024u;
    const int aoff = lds_byte(wr * 64 + fr, fq * 8), boff = lds_byte(wc * 32 + fr, fq * 8);
#define PG8_SA(b, h) (((b) * 2 + (h)) * HTB)
#define PG8_SB(b, h) ((4 + (b) * 2 + (h)) * HTB)
#define PG8_STAGE(bufoff, gbase, voff) do { _Pragma("unroll") for (int _i = 0; _i < 2; ++_i) \
        __builtin_amdgcn_global_load_lds((const unsigned*)((const char*)(gbase) + (voff)[_i]), (LAS unsigned*)(lds + (bufoff) + ldsw + _i * 8192), 16, 0, 0); } while (0)
#define PG8_LDA(dst, b, h) do { _Pragma("unroll") for (int m = 0; m < 4; ++m) _Pragma("unroll") for (int k = 0; k < 2; ++k) dst[m][k] = *(const LAS bf16x8*)(lds + PG8_SA(b, h) + aoff + m * 2048 + k * 1024); } while (0)
#define PG8_LDB(dst, b, h) do { _Pragma("unroll") for (int n = 0; n < 2; ++n) _Pragma("unroll") for (int k = 0; k < 2; ++k) dst[n][k] = *(const LAS bf16x8*)(lds + PG8_SB(b, h) + boff + n * 2048 + k * 1024); } while (0)
#define PG8_MMA(ai, bj, At, Bt) do { __builtin_amdgcn_s_setprio(1); _Pragma("unroll") for (int m = 0; m < 4; ++m) _Pragma("unroll") for (int n = 0; n < 2; ++n) _Pragma("unroll") for (int k = 0; k < 2; ++k) \
        acc[ai][bj][m][n] = __builtin_amdgcn_mfma_f32_16x16x32_bf16(Bt[n][k], At[m][k], acc[ai][bj][m][n], 0, 0, 0); __builtin_amdgcn_s_setprio(0); } while (0)
#define PG8_WAIT_V(n) asm volatile("s_waitcnt vmcnt(" #n ")" ::: "memory")
#define PG8_WAIT_L(n) asm volatile("s_waitcnt lgkmcnt(" #n ")" ::: "memory")
#define PG8_BAR __builtin_amdgcn_s_barrier()
#define PG8_SCHED __builtin_amdgcn_sched_barrier(0)
    Unit cur, nxt; int ui = 0;
    if (!S.next(0, cur)) return;
    Acc acc;
#pragma unroll
    for (int a = 0; a < 2; ++a)
#pragma unroll
        for (int b = 0; b < 2; ++b)
#pragma unroll
            for (int m = 0; m < 4; ++m)
#pragma unroll
                for (int n = 0; n < 2; ++n) acc[a][b][m][n] = (f32x4){0.f, 0.f, 0.f, 0.f};
    bf16x8 At[4][2], B0[2][2], B1[2][2];
    const char* cA = (const char*)g.A + (size_t)cur.pm * tstepA; const char* cB = (const char*)g.Bt + (size_t)cur.pn * tstepB;
    const int ksp = g.ksp; const char* cA2 = (const char*)g.A2 + (size_t)cur.pm * tstepA - (size_t)ksp * kstep;
#define PG8_APTR(kt) (((kt) < ksp ? cA : cA2) + (size_t)(kt) * kstep)
    PG8_STAGE(PG8_SB(0, 0), cB, voffB); PG8_STAGE(PG8_SB(0, 1), cB + hstepB, voffB); PG8_STAGE(PG8_SA(0, 0), cA, voffA); PG8_STAGE(PG8_SA(0, 1), cA + hstepA, voffA);
    if (wr == 1) PG8_BAR;
    PG8_WAIT_V(2); PG8_BAR;
    PG8_STAGE(PG8_SB(1, 0), cB + kstep, voffB); PG8_STAGE(PG8_SA(1, 0), cA + kstep, voffA); PG8_STAGE(PG8_SB(1, 1), cB + hstepB + kstep, voffB);
    PG8_WAIT_V(6); PG8_BAR;
    for (;;) {
        const bool has_next = S.next(ui + 1, nxt);
        const char* nA = has_next ? (const char*)g.A + (size_t)nxt.pm * tstepA : cA; const char* nB = has_next ? (const char*)g.Bt + (size_t)nxt.pn * tstepB : cB;
        const char* nA2 = has_next ? (const char*)g.A2 + (size_t)nxt.pm * tstepA - (size_t)ksp * kstep : cA2;
#pragma unroll 1
        for (int t = 0; t < nt; t += 2) {
            const bool last = (t == nt - 2);
            const char* a1 = PG8_APTR(t + 1);
            const char* a2 = last ? nA : PG8_APTR(t + 2); const char* b2 = last ? nB : cB + (size_t)(t + 2) * kstep;
            const char* a3 = a2 + kstep; const char* b3 = b2 + kstep;
            PG8_LDB(B0, 0, 0); PG8_LDB(B1, 0, 1); PG8_SCHED; PG8_LDA(At, 0, 0); PG8_STAGE(PG8_SA(1, 1), a1 + hstepA, voffA);
            PG8_WAIT_V(8); PG8_WAIT_L(0); PG8_BAR; PG8_MMA(0, 0, At, B0); PG8_MMA(0, 1, At, B1); PG8_BAR; PG8_SCHED;
            PG8_LDA(At, 0, 1); PG8_STAGE(PG8_SB(0, 0), b2, voffB); PG8_STAGE(PG8_SB(0, 1), b2 + hstepB, voffB); PG8_STAGE(PG8_SA(0, 0), a2, voffA);
            PG8_WAIT_V(8); PG8_WAIT_L(0); PG8_BAR; PG8_MMA(1, 0, At, B0); PG8_MMA(1, 1, At, B1); PG8_BAR; PG8_SCHED;
            PG8_LDB(B0, 1, 0); PG8_LDB(B1, 1, 1); PG8_SCHED; PG8_LDA(At, 1, 0); PG8_STAGE(PG8_SA(0, 1), a2 + hstepA, voffA);
            PG8_WAIT_V(8); PG8_WAIT_L(0); PG8_BAR; PG8_MMA(0, 0, At, B0); PG8_MMA(0, 1, At, B1); PG8_BAR; PG8_SCHED;
            PG8_LDA(At, 1, 1); PG8_STAGE(PG8_SB(1, 0), b3, voffB); PG8_STAGE(PG8_SB(1, 1), b3 + hstepB, voffB); PG8_STAGE(PG8_SA(1, 0), a3, voffA);
            PG8_WAIT_V(8); PG8_WAIT_L(0); PG8_BAR; PG8_MMA(1, 0, At, B0); PG8_MMA(1, 1, At, B1); PG8_BAR; PG8_SCHED;
        }
        if (wr == 0) PG8_BAR;
        { int t2 = threadIdx.x; asm volatile("" : "+v"(t2)); const int l2 = t2 & 63; E(acc, cur, wr, wc, l2 & 15, l2 >> 4); }
        if (!has_next) break;
#pragma unroll
        for (int a = 0; a < 2; ++a)
#pragma unroll
            for (int b = 0; b < 2; ++b)
#pragma unroll
                for (int m = 0; m < 4; ++m)
#pragma unroll
                    for (int n = 0; n < 2; ++n) acc[a][b][m][n] = (f32x4){0.f, 0.f, 0.f, 0.f};
        cur = nxt; cA = nA; cB = nB; cA2 = nA2; ++ui;
        if (wr == 1) PG8_BAR;
    }
    PG8_WAIT_V(0);
    PG8_BAR;
#undef PG8_APTR
#undef PG8_SA
#undef PG8_SB
#undef PG8_STAGE
#undef PG8_LDA
#undef PG8_LDB
#undef PG8_MMA
#undef PG8_WAIT_V
#undef PG8_WAIT_L
#undef PG8_BAR
#undef PG8_SCHED
}
}

__device__ __forceinline__ void transpose_item(const Params& p, int jidx, int item, LAS float* scr, int lane) {
    const Job& jb = p.jobs[jidx];
    const float* src = jb.src; bf16_t* dst = jb.dst;
    const int ldsrc = jb.ldsrc, G = jb.G, lddst = jb.lddst, Nc = jb.Nc;
    const float scale = jb.scale;
    const int nblk = Nc / 32, kb = item / nblk, nb = item % nblk, k0 = 64 * kb, j0 = 32 * nb;
    const int grp = j0 / G, jin = j0 % G;
    const int srccol0 = jb.c0 + grp * jb.sstride + jin, dstrow0 = jb.r0 + grp * jb.dstride + jin;
    if (src) {
#pragma unroll 8
        for (int i = 0; i < 32; ++i) { const int kk = 2 * i + (lane >> 5); scr[kk * 33 + (lane & 31)] = src[(size_t)(k0 + kk) * ldsrc + srccol0 + (lane & 31)] * scale; }
    } else {
#pragma unroll 8
        for (int i = 0; i < 32; ++i) { const int kk = 2 * i + (lane >> 5); scr[kk * 33 + (lane & 31)] = 0.f; }
    }
    LDS_WAIT(); asm volatile("" ::: "memory");
    const int c = lane & 7;
    f32x4 g0 = (f32x4){1.f, 1.f, 1.f, 1.f}, g1 = g0;
    if (src && jb.kscale) { g0 = *(const f32x4*)(jb.kscale + k0 + 8 * c); g1 = *(const f32x4*)(jb.kscale + k0 + 8 * c + 4); }
#pragma unroll
    for (int j = 0; j < 4; ++j) { const int n = (lane >> 3) + 8 * j; const LAS float* s = scr + (8 * c) * 33 + n;
        u32x4 o; o.x = pk_bf16(s[0 * 33] * g0.x, s[1 * 33] * g0.y); o.y = pk_bf16(s[2 * 33] * g0.z, s[3 * 33] * g0.w); o.z = pk_bf16(s[4 * 33] * g1.x, s[5 * 33] * g1.y); o.w = pk_bf16(s[6 * 33] * g1.z, s[7 * 33] * g1.w);
        *(u32x4*)(dst + (size_t)(dstrow0 + n) * lddst + jb.dk0 + k0 + 8 * c) = o; }
    LDS_WAIT(); asm volatile("" ::: "memory");
}
__device__ __forceinline__ void weights_phase(const Params& p, LAS unsigned char* lds, int gw, int NGW, int wave, int lane) {
    LAS float* scr = (LAS float*)(lds + wave * 8704);
    for (int it = gw; it < p.nitems; it += NGW) {
        int j = 0;
        for (int q = 1; q < p.njobs; ++q) if (p.jobs[q].item0 <= it) j = q;
        j = __builtin_amdgcn_readfirstlane(j);
        transpose_item(p, j, it - p.jobs[j].item0, scr, lane);
    }
}

__device__ __forceinline__ void norm_phase(const float* x, const float* g, bf16_t* out, int gw, int NGW, int lane) {
    f32x4 gv[4];
#pragma unroll
    for (int j = 0; j < 4; ++j) gv[j] = *((const f32x4*)g + lane + 64 * j);
    for (int m = gw; m < T_ / 2; m += NGW) {
        const f32x4* xr = (const f32x4*)(x + (size_t)m * D_) + lane; const f32x4* xq = xr + (size_t)(T_ / 2) * (D_ / 4);
        f32x4 v[4], u[4]; float s = 0.f, t = 0.f;
#pragma unroll
        for (int j = 0; j < 4; ++j) { v[j] = xr[64 * j]; u[j] = xq[64 * j]; }
#pragma unroll
        for (int j = 0; j < 4; ++j) { s += (v[j].x * v[j].x + v[j].y * v[j].y) + (v[j].z * v[j].z + v[j].w * v[j].w); t += (u[j].x * u[j].x + u[j].y * u[j].y) + (u[j].z * u[j].z + u[j].w * u[j].w); }
        const float rs = 1.0f / sqrtf(wave_sum(s) * (1.f / D_) + 1e-6f), rt = 1.0f / sqrtf(wave_sum(t) * (1.f / D_) + 1e-6f);
        u32x2* o = (u32x2*)(out + (size_t)m * D_) + lane; u32x2* oq = o + (size_t)(T_ / 2) * (D_ / 4);
#pragma unroll
        for (int j = 0; j < 4; ++j) { const f32x4 y = v[j] * rs * gv[j]; u32x2 w; w.x = pk_bf16(y.x, y.y); w.y = pk_bf16(y.z, y.w); o[64 * j] = w;
                                      const f32x4 z = u[j] * rt * gv[j]; u32x2 w2; w2.x = pk_bf16(z.x, z.y); w2.y = pk_bf16(z.z, z.w); oq[64 * j] = w2; }
    }
}
__device__ __forceinline__ f32x4 ld_bf4(const bf16_t* p) { const u32x2 w = *(const u32x2*)p; return (f32x4){bf_lo(w.x), bf_hi(w.x), bf_lo(w.y), bf_hi(w.y)}; }
__device__ __forceinline__ void final_norm_phase(const bf16_t* x, int src_off, float* out, const float* g, int r0, int r1, const bf16_t* cx, bf16_t* cpy, int c0, int c1, int gw, int NGW, int lane) {
    f32x4 gv[4];
#pragma unroll
    for (int j = 0; j < 4; ++j) gv[j] = *((const f32x4*)g + lane + 64 * j);
    for (int m = r0 + gw; m < r1; m += NGW) {
        const bf16_t* xr = x + (size_t)(m - src_off) * D_ + 4 * lane;
        f32x4 v[4]; float s = 0.f;
#pragma unroll
        for (int j = 0; j < 4; ++j) { v[j] = ld_bf4(xr + 256 * j); s += (v[j].x * v[j].x + v[j].y * v[j].y) + (v[j].z * v[j].z + v[j].w * v[j].w); }
        const float rstd = 1.0f / sqrtf(wave_sum(s) * (1.f / D_) + 1e-6f);
        f32x4* o = (f32x4*)(out + (size_t)m * D_) + lane;
#pragma unroll
        for (int j = 0; j < 4; ++j) o[64 * j] = v[j] * rstd * gv[j];
    }
    for (int m = c0 + gw; m < c1; m += NGW) {
        const u32x4* sp = (const u32x4*)(cx + (size_t)m * D_) + lane; u32x4* dp = (u32x4*)(cpy + (size_t)(m - c0) * D_) + lane;
        dp[0] = sp[0]; dp[64] = sp[64];
    }
}
__device__ __forceinline__ void mix_phase(const bf16_t* x, const float* g, const float* mu0, const float* mu1, const float* mu2, bf16_t* o0, size_t ostride, int ld, int gw, int NGW, int lane) {
    for (int m = gw; m < T_; m += NGW) {
        const int s_idx = m & (S_ - 1);
        const bf16_t* xr = x + (size_t)m * D_ + 4 * lane;
        f32x4 v[4], pv[4]; float s = 0.f, ps = 0.f;
#pragma unroll
        for (int j = 0; j < 4; ++j) { v[j] = ld_bf4(xr + 256 * j); s += (v[j].x * v[j].x + v[j].y * v[j].y) + (v[j].z * v[j].z + v[j].w * v[j].w); }
        if (s_idx > 0) {
#pragma unroll
            for (int j = 0; j < 4; ++j) { pv[j] = ld_bf4(xr + 256 * j - D_); ps += (pv[j].x * pv[j].x + pv[j].y * pv[j].y) + (pv[j].z * pv[j].z + pv[j].w * pv[j].w); }
        } else {
#pragma unroll
            for (int j = 0; j < 4; ++j) pv[j] = (f32x4){0.f, 0.f, 0.f, 0.f};
        }
        const float rstd = 1.0f / sqrtf(wave_sum(s) * (1.f / D_) + 1e-6f);
        const float prstd = 1.0f / sqrtf(wave_sum(ps) * (1.f / D_) + 1e-6f);
#pragma unroll
        for (int j = 0; j < 4; ++j) {
            const f32x4 gv = *((const f32x4*)g + lane + 64 * j);
            const f32x4 h = v[j] * rstd * gv, hh = pv[j] * prstd * gv - h;
            const f32x4 m0 = *((const f32x4*)mu0 + lane + 64 * j), m1 = *((const f32x4*)mu1 + lane + 64 * j), m2 = *((const f32x4*)mu2 + lane + 64 * j);
            const f32x4 y0 = h + hh * m0, y1 = h + hh * m1, y2 = h + hh * m2;
            u32x2 w;
            w.x = pk_bf16(y0.x, y0.y); w.y = pk_bf16(y0.z, y0.w); *((u32x2*)(o0 + (size_t)m * ld) + lane + 64 * j) = w;
            w.x = pk_bf16(y1.x, y1.y); w.y = pk_bf16(y1.z, y1.w); *((u32x2*)(o0 + ostride + (size_t)m * ld) + lane + 64 * j) = w;
            w.x = pk_bf16(y2.x, y2.y); w.y = pk_bf16(y2.z, y2.w); *((u32x2*)(o0 + 2 * ostride + (size_t)m * ld) + lane + 64 * j) = w;
        }
    }
}
__device__ __forceinline__ void latents_phase(bf16_t* ZL, const float* qn, const float* kvn, const int* pos, bf16_t* KPE, f32x2* ROPE, int gw, int NGW, int lane) {
    for (int m = gw; m < T_; m += NGW) {
        bf16_t* zr = ZL + (size_t)m * 1024;
        { u32x4 w = *((const u32x4*)zr + lane); float f[8] = {bf_lo(w.x), bf_hi(w.x), bf_lo(w.y), bf_hi(w.y), bf_lo(w.z), bf_hi(w.z), bf_lo(w.w), bf_hi(w.w)};
          float s = 0.f;
#pragma unroll
          for (int e = 0; e < 8; ++e) s += f[e] * f[e];
          const float rstd = 1.0f / sqrtf(wave_sum(s) * (1.f / 512.f) + 1e-6f);
          const f32x4 g0 = *((const f32x4*)qn + 2 * lane), g1 = *((const f32x4*)qn + 2 * lane + 1);
          u32x4 o; o.x = pk_bf16(f[0] * rstd * g0.x, f[1] * rstd * g0.y); o.y = pk_bf16(f[2] * rstd * g0.z, f[3] * rstd * g0.w);
          o.z = pk_bf16(f[4] * rstd * g1.x, f[5] * rstd * g1.y); o.w = pk_bf16(f[6] * rstd * g1.z, f[7] * rstd * g1.w);
          *((u32x4*)zr + lane) = o; }
        { u32x2 w = *((const u32x2*)(zr + 512) + lane); float f[4] = {bf_lo(w.x), bf_hi(w.x), bf_lo(w.y), bf_hi(w.y)};
          const float s = (f[0] * f[0] + f[1] * f[1]) + (f[2] * f[2] + f[3] * f[3]);
          const float rstd = 1.0f / sqrtf(wave_sum(s) * (1.f / 256.f) + 1e-6f);
          const f32x4 g0 = *((const f32x4*)kvn + lane);
          u32x2 o; o.x = pk_bf16(f[0] * rstd * g0.x, f[1] * rstd * g0.y); o.y = pk_bf16(f[2] * rstd * g0.z, f[3] * rstd * g0.w);
          *((u32x2*)(zr + 512) + lane) = o; }
        if (lane < 32) {
            const float invf = fexp2(-(float)lane * (13.287712379549449f / 32.0f));
            const float ang = (float)pos[m] * invf;
            const double rev = (double)ang * 0.15915494309189535;
            const float fr = (float)(rev - __builtin_rint(rev));
            const float cs = __builtin_amdgcn_cosf(fr), sn = __builtin_amdgcn_sinf(fr);
            ROPE[(size_t)m * 32 + lane] = (f32x2){cs, sn};
            const float x1 = __uint_as_float((unsigned)zr[768 + lane] << 16), x2 = __uint_as_float((unsigned)zr[800 + lane] << 16);
            const unsigned o1 = pk_bf16(x1 * cs - x2 * sn, 0.f), o2 = pk_bf16(x1 * sn + x2 * cs, 0.f);
            KPE[(size_t)m * 64 + lane] = (bf16_t)(o1 & 0xffffu); KPE[(size_t)m * 64 + 32 + lane] = (bf16_t)(o2 & 0xffffu);
        }
    }
}

__device__ __forceinline__ void conv_phase(LAS unsigned char* lds, const bf16_t* U, const float* cw, const float* cb, const float* lg, const float* lb, bf16_t* CONV, int vcu, int G) {
    const int tid = threadIdx.x, lane = tid & 63, wid = tid >> 6;
    LAS unsigned* ub = (LAS unsigned*)lds;
    LAS float* part = (LAS float*)(lds + 62 * 2048);
    LAS float* stat = part + 512;
    f32x2 W[31];
#pragma unroll
    for (int w = 0; w < 31; ++w) W[w] = *(const f32x2*)(cw + w * D_ + 2 * tid);
    const f32x2 bias = *(const f32x2*)(cb + 2 * tid), lgv = *(const f32x2*)(lg + 2 * tid), lbv = *(const f32x2*)(lb + 2 * tid);
    for (int item = vcu; item < NB_ * 64; item += G) {
        const int b = item >> 6, s0 = (item & 63) * 32;
        const size_t rowb = (size_t)b * S_;
        __syncthreads();
        for (int idx = tid; idx < 62 * 128; idx += 512) {
            const int r = idx >> 7, ch = idx & 127, s = s0 - 30 + r;
            u32x4 v = (u32x4){0u, 0u, 0u, 0u};
            if (s >= 0) v = *((const u32x4*)(U + (rowb + s) * D_) + ch);
            *((LAS u32x4*)(ub + r * 512) + ch) = v;
        }
        __syncthreads();
        f32x2 acc[32];
#pragma unroll
        for (int t = 0; t < 32; ++t) {
            float a0 = bias.x, a1 = bias.y;
#pragma unroll
            for (int w = 0; w < 31; ++w) { const unsigned uu = ub[(t + w) * 512 + tid];
                asm("v_fma_f32 %0, %1, %2, %0" : "+v"(a0) : "v"(bf_lo(uu)), "v"(W[w].x)); asm("v_fma_f32 %0, %1, %2, %0" : "+v"(a1) : "v"(bf_hi(uu)), "v"(W[w].y)); }
            acc[t] = (f32x2){a0, a1};
        }
#pragma unroll
        for (int t = 0; t < 32; ++t) {
            const float s1 = wave_sum(acc[t].x + acc[t].y), s2 = wave_sum(acc[t].x * acc[t].x + acc[t].y * acc[t].y);
            if (lane == 0) { part[(wid * 32 + t) * 2] = s1; part[(wid * 32 + t) * 2 + 1] = s2; }
        }
        __syncthreads();
        if (tid < 32) {
            float s1 = 0.f, s2 = 0.f;
#pragma unroll
            for (int w = 0; w < 8; ++w) { s1 += part[(w * 32 + tid) * 2]; s2 += part[(w * 32 + tid) * 2 + 1]; }
            const float mean = s1 * (1.f / D_), var = fmaxf(s2 * (1.f / D_) - mean * mean, 0.f);
            stat[tid * 2] = mean; stat[tid * 2 + 1] = 1.0f / sqrtf(var + 1e-5f);
        }
        __syncthreads();
#pragma unroll
        for (int t = 0; t < 32; ++t) {
            const float mean = stat[t * 2], rstd = stat[t * 2 + 1];
            const f32x2 hn = (acc[t] - mean) * rstd * lgv + lbv;
            const float o0 = hn.x * sigmoidf_(hn.x), o1 = hn.y * sigmoidf_(hn.y);
            *((unsigned*)(CONV + (rowb + s0 + t) * D_) + tid) = pk_bf16(o0, o1);
        }
    }
    __syncthreads();
}

namespace att {
constexpr int KP = 400, VP = 144, KT = 64 * KP, VT = 128 * VP, STG = KT + VT;
__device__ __forceinline__ void attn_unit(LAS unsigned char* lds, int b, int h, int qb, const bf16_t* Q, const bf16_t* KN, const bf16_t* KPE, const bf16_t* VTg, const f32x2* ROPE, bf16_t* ATT, const unsigned char* wsb) {
    int tid = threadIdx.x; asm volatile("" : "+v"(tid));
    const int lane = tid & 63, r32 = lane & 31, hi = lane >> 5; const int wid = __builtin_amdgcn_readfirstlane(tid >> 6);
    const size_t rowb = (size_t)b * S_; const int q0 = qb * 256;
    const int NT = (q0 + 256) / 64;
    const char* gbase = (const char*)wsb;
    const unsigned kn_off = (unsigned)((const char*)(KN + ((size_t)(b * 8 + h) * S_ + (tid >> 4)) * 128 + 8 * (tid & 15)) - gbase);
    const unsigned kp_off = (unsigned)((const char*)(KPE + (rowb + (tid >> 3)) * 64 + 8 * (tid & 7)) - gbase);
    const unsigned v_off = (unsigned)((const char*)(VTg + ((size_t)(b * 8 + h) * 32 * 128 + (tid >> 3)) * 64 + 8 * (tid & 7)) - gbase);
    const int kn_dst = (tid >> 4) * KP + (tid & 15) * 16, kp_dst = (tid >> 3) * KP + 256 + (tid & 7) * 16, v_dst = KT + (tid >> 3) * VP + (tid & 7) * 16;
    u32x4 kr[3], vr[2];
#define ATT_LOAD(t) do { kr[0] = *(const u32x4*)(gbase + (kn_off + (unsigned)(t) * 16384u)); kr[1] = *(const u32x4*)(gbase + (kn_off + (unsigned)(t) * 16384u + 8192u)); \
                         kr[2] = *(const u32x4*)(gbase + (kp_off + (unsigned)(t) * (64u * 64u * 2u))); \
                         vr[0] = *(const u32x4*)(gbase + (v_off + (unsigned)(t) * 16384u)); vr[1] = *(const u32x4*)(gbase + (v_off + (unsigned)(t) * 16384u + 8192u)); } while (0)
#define ATT_STORE(st) do { *(LAS u32x4*)(lds + (st) * STG + kn_dst) = kr[0]; *(LAS u32x4*)(lds + (st) * STG + kn_dst + 32 * KP) = kr[1]; *(LAS u32x4*)(lds + (st) * STG + kp_dst) = kr[2]; \
                          *(LAS u32x4*)(lds + (st) * STG + v_dst) = vr[0]; *(LAS u32x4*)(lds + (st) * STG + v_dst + 64 * VP) = vr[1]; } while (0)
    ATT_LOAD(0);
    const size_t qrow = rowb + q0 + wid * 32 + r32;
    bf16x8 qf[12];
#pragma unroll
    for (int d0 = 0; d0 < 12; ++d0) qf[d0] = *(const bf16x8*)(Q + qrow * 1536 + h * 192 + d0 * 16 + hi * 8);
#pragma unroll
    for (int dd = 0; dd < 2; ++dd) {
        const f32x2* rp = ROPE + qrow * 32 + 16 * dd + 8 * hi;
        u32x4 a = __builtin_bit_cast(u32x4, qf[8 + dd]), c = __builtin_bit_cast(u32x4, qf[10 + dd]);
        unsigned ao[4], co[4];
#pragma unroll
        for (int w = 0; w < 4; ++w) {
            const f32x2 cs0 = rp[2 * w], cs1 = rp[2 * w + 1];
            const float x1a = bf_lo(a[w]), x1b = bf_hi(a[w]), x2a = bf_lo(c[w]), x2b = bf_hi(c[w]);
            ao[w] = pk_bf16(x1a * cs0.x - x2a * cs0.y, x1b * cs1.x - x2b * cs1.y);
            co[w] = pk_bf16(x1a * cs0.y + x2a * cs0.x, x1b * cs1.y + x2b * cs1.x);
        }
        qf[8 + dd] = __builtin_bit_cast(bf16x8, (u32x4){ao[0], ao[1], ao[2], ao[3]});
        qf[10 + dd] = __builtin_bit_cast(bf16x8, (u32x4){co[0], co[1], co[2], co[3]});
    }
    f32x16 o[4];
#pragma unroll
    for (int db = 0; db < 4; ++db)
#pragma unroll
        for (int r = 0; r < 16; ++r) o[db][r] = 0.f;
    float mrun = -1e30f, lrun = 0.f;
#pragma unroll
    for (int d0 = 0; d0 < 12; ++d0) asm volatile("" : "+v"(qf[d0]));
    const int kperm = 16 * ((r32 >> 2) & 1) + 4 * (r32 >> 3) + (r32 & 3);
    const int koff = kperm * KP + hi * 16;
    const int voff = KT + r32 * VP + hi * 32;
    const int qrel = wid * 32 + r32;
    ATT_STORE(0);
    __syncthreads();
    for (int t = 0; t < NT; ++t) {
        const int st = t & 1;
        if (t + 1 < NT) ATT_LOAD(t + 1);
        const int jb = t - (NT - 4);
        if (jb <= (wid >> 1)) {
            const LAS unsigned char* kb = lds + st * STG + koff;
            f32x16 p0, p1;
#pragma unroll
            for (int r = 0; r < 16; ++r) { p0[r] = 0.f; p1[r] = 0.f; }
#pragma unroll
            for (int d0 = 0; d0 < 12; ++d0) {
                const bf16x8 k0 = *(const LAS bf16x8*)(kb + d0 * 32), k1 = *(const LAS bf16x8*)(kb + 32 * KP + d0 * 32);
                p0 = __builtin_amdgcn_mfma_f32_32x32x16_bf16(k0, qf[d0], p0, 0, 0, 0);
                p1 = __builtin_amdgcn_mfma_f32_32x32x16_bf16(k1, qf[d0], p1, 0, 0, 0);
            }
            if (jb >= 0) {
                const int kv0 = 64 * jb + 16 * hi;
#pragma unroll
                for (int r = 0; r < 16; ++r) { if (kv0 + r > qrel) p0[r] = -INFINITY; if (kv0 + 32 + r > qrel) p1[r] = -INFINITY; }
            }
            float rm = fmaxf(p0[0], p1[0]);
#pragma unroll
            for (int r = 1; r < 16; ++r) rm = fmaxf(rm, fmaxf(p0[r], p1[r]));
            rm = fmaxf(rm, __shfl_xor(rm, 32));
            const float mnew = fmaxf(mrun, rm), alpha = fexp2(mrun - mnew);
            mrun = mnew;
            float ls = 0.f;
#pragma unroll
            for (int r = 0; r < 16; ++r) { p0[r] = fexp2(p0[r] - mnew); p1[r] = fexp2(p1[r] - mnew); ls += p0[r] + p1[r]; }
            lrun = lrun * alpha + ls;
#pragma unroll
            for (int db = 0; db < 4; ++db)
#pragma unroll
                for (int r = 0; r < 16; ++r) o[db][r] *= alpha;
            const LAS unsigned char* vb = lds + st * STG + voff;
#pragma unroll
            for (int gg = 0; gg < 2; ++gg)
#pragma unroll
                for (int j = 0; j < 2; ++j) {
                    u32x4 pw;
                    if (gg == 0) { pw.x = pk_bf16(p0[8 * j], p0[8 * j + 1]); pw.y = pk_bf16(p0[8 * j + 2], p0[8 * j + 3]); pw.z = pk_bf16(p0[8 * j + 4], p0[8 * j + 5]); pw.w = pk_bf16(p0[8 * j + 6], p0[8 * j + 7]); }
                    else         { pw.x = pk_bf16(p1[8 * j], p1[8 * j + 1]); pw.y = pk_bf16(p1[8 * j + 2], p1[8 * j + 3]); pw.z = pk_bf16(p1[8 * j + 4], p1[8 * j + 5]); pw.w = pk_bf16(p1[8 * j + 6], p1[8 * j + 7]); }
                    const bf16x8 pf = __builtin_bit_cast(bf16x8, pw);
#pragma unroll
                    for (int db = 0; db < 4; ++db) {
                        const bf16x8 vf = *(const LAS bf16x8*)(vb + db * 32 * VP + gg * 64 + j * 16);
                        o[db] = __builtin_amdgcn_mfma_f32_32x32x16_bf16(vf, pf, o[db], 0, 0, 0);
                    }
                }
        }
        if (t + 1 < NT) ATT_STORE(st ^ 1);
        __syncthreads();
    }
    const float ltot = lrun + __shfl_xor(lrun, 32);
    const float inv = 1.0f / ltot;
    bf16_t* orow = ATT + qrow * D_ + h * 128;
#pragma unroll
    for (int db = 0; db < 4; ++db)
#pragma unroll
        for (int rg = 0; rg < 4; ++rg) {
            u32x2 w; w.x = pk_bf16(o[db][4 * rg] * inv, o[db][4 * rg + 1] * inv); w.y = pk_bf16(o[db][4 * rg + 2] * inv, o[db][4 * rg + 3] * inv);
            *(u32x2*)(orow + 32 * db + 8 * rg + 4 * hi) = w;
        }
#undef ATT_LOAD
#undef ATT_STORE
}
}

namespace scan {
constexpr int CH = 32;
constexpr int O_NKK = 0, O_W = CH * 64, O_BV = 2 * CH * 64, O_KP = 3 * CH * 64, O_RR = 4 * CH * 64, O_VV = 5 * CH * 64, O_GG = 6 * CH * 64, O_BON = 7 * CH * 64, O_YB = 7 * CH * 64 + 64, O_GAM = O_YB + CH * 64, O_VT = O_GAM + 64;
__device__ __forceinline__ float red8(float x) {
    x += __int_as_float(__builtin_amdgcn_update_dpp(0, __float_as_int(x), 0xB1, 0xF, 0xF, true));
    x += __int_as_float(__builtin_amdgcn_update_dpp(0, __float_as_int(x), 0x4E, 0xF, 0xF, true));
    x += __int_as_float(__builtin_amdgcn_update_dpp(0, __float_as_int(x), 0x141, 0xF, 0xF, true));
    return x;
}
__device__ __forceinline__ void scan_unit(LAS unsigned char* lds, int b, int h, const bf16_t* R, const bf16_t* K, const bf16_t* V, const bf16_t* WAG,
                                          const float* k_k, const float* k_a, const float* r_k, const float* ln_g, const float* ln_b, bf16_t* YG) {
    const int tid = threadIdx.x;
    LAS float* L = (LAS float*)lds;
    const int i = tid >> 3, c = tid & 7;
    const int ps = tid >> 4, pj = (tid & 15) * 4;
    const size_t rowb = (size_t)b * S_;
    const int hc = h * 64 + pj;
    const f32x4 kk4 = *(const f32x4*)(k_k + hc), ka4 = *(const f32x4*)(k_a + hc), rk4 = *(const f32x4*)(r_k + hc), lg4 = *(const f32x4*)(ln_g + hc), lb4 = *(const f32x4*)(ln_b + hc);
    f32x2 S2[4];
#pragma unroll
    for (int j = 0; j < 4; ++j) S2[j] = (f32x2){0.f, 0.f};
    u32x2 pr, pk, pvv, pe, pa, pg;
#define SCAN_LOAD(chk) do { const size_t tt = rowb + (size_t)(chk) * CH + ps; \
        pr = *(const u32x2*)(R + tt * D_ + hc); pk = *(const u32x2*)(K + tt * D_ + hc); pvv = *(const u32x2*)(V + tt * D_ + hc); \
        pe = *(const u32x2*)(WAG + tt * 3072 + hc); pa = *(const u32x2*)(WAG + tt * 3072 + 1024 + hc); pg = *(const u32x2*)(WAG + tt * 3072 + 2048 + hc); } while (0)
    SCAN_LOAD(0);
    for (int chk = 0; chk < S_ / CH; ++chk) {
        __syncthreads();
        {
            const f32x4 r4 = {bf_lo(pr.x), bf_hi(pr.x), bf_lo(pr.y), bf_hi(pr.y)}, k4 = {bf_lo(pk.x), bf_hi(pk.x), bf_lo(pk.y), bf_hi(pk.y)}, v4 = {bf_lo(pvv.x), bf_hi(pvv.x), bf_lo(pvv.y), bf_hi(pvv.y)};
            const f32x4 e4 = {h_lo(pe.x), h_hi(pe.x), h_lo(pe.y), h_hi(pe.y)}, a4 = {h_lo(pa.x), h_hi(pa.x), h_lo(pa.y), h_hi(pa.y)}, g4 = {h_lo(pg.x), h_hi(pg.x), h_lo(pg.y), h_hi(pg.y)};
            const int o = ps * 64 + pj;
            const f32x4 kkr = k4 * kk4;
            const float ss = sum16((kkr.x * kkr.x + kkr.y * kkr.y) + (kkr.z * kkr.z + kkr.w * kkr.w));
            const float inv = 1.0f / fmaxf(sqrtf(ss), 1e-12f);
            const f32x4 kk = kkr * inv;
            const f32x4 kp = k4 * (1.0f + (a4 - 1.0f) * ka4);
            const f32x4 bv = kk * a4;
            const f32x4 bt = r4 * kp * rk4;
            const float bon = sum16((bt.x + bt.y) + (bt.z + bt.w));
            f32x4 cum = e4;
            { const int lg = (tid >> 4) & 3;
              f32x4 u; u.x = __shfl_up(cum.x, 16); u.y = __shfl_up(cum.y, 16); u.z = __shfl_up(cum.z, 16); u.w = __shfl_up(cum.w, 16);
              if (lg >= 1) cum += u;
              u.x = __shfl_up(cum.x, 32); u.y = __shfl_up(cum.y, 32); u.z = __shfl_up(cum.z, 32); u.w = __shfl_up(cum.w, 32);
              if (lg >= 2) cum += u;
              if (lg == 3) *(LAS f32x4*)(L + O_W + (tid >> 6) * 64 + pj) = cum; }
            __syncthreads();
            { const int wv = tid >> 6;
              for (int w2 = 0; w2 < wv; ++w2) cum += *(const LAS f32x4*)(L + O_W + w2 * 64 + pj); }
            f32x4 gs, gp, gi;
            gs.x = fexp2(-cum.x * LOG2E); gs.y = fexp2(-cum.y * LOG2E); gs.z = fexp2(-cum.z * LOG2E); gs.w = fexp2(-cum.w * LOG2E);
            gi.x = fexp2(cum.x * LOG2E); gi.y = fexp2(cum.y * LOG2E); gi.z = fexp2(cum.z * LOG2E); gi.w = fexp2(cum.w * LOG2E);
            const f32x4 cp = cum - e4;
            gp.x = fexp2(-cp.x * LOG2E); gp.y = fexp2(-cp.y * LOG2E); gp.z = fexp2(-cp.z * LOG2E); gp.w = fexp2(-cp.w * LOG2E);
            *(LAS f32x4*)(L + O_NKK + o) = -(kk * gp); *(LAS f32x4*)(L + O_BV + o) = bv * gi; *(LAS f32x4*)(L + O_KP + o) = kp * gi;
            *(LAS f32x4*)(L + O_RR + o) = r4 * gs; *(LAS f32x4*)(L + O_VV + o) = v4; *(LAS f32x4*)(L + O_GG + o) = g4;
            if (ps == CH - 1) *(LAS f32x4*)(L + O_GAM + pj) = gs;
            { LAS float* vt = L + O_VT + (ps >> 2) * 256 + pj * 4 + (ps & 3); vt[0] = v4.x; vt[4] = v4.y; vt[8] = v4.z; vt[12] = v4.w; }
            if ((tid & 15) == 0) L[O_BON + ps] = bon;
        }
        __syncthreads();
        if (chk + 1 < S_ / CH) SCAN_LOAD(chk + 1);
        f32x4 vq = (f32x4){0.f, 0.f, 0.f, 0.f};
#pragma unroll 4
        for (int s = 0; s < CH; ++s) {
            const int o = s * 64 + 8 * c;
            if ((s & 3) == 0) vq = *(const LAS f32x4*)(L + O_VT + (s >> 2) * 256 + i * 4);
            const f32x4 n0 = *(const LAS f32x4*)(L + O_NKK + o), n1 = *(const LAS f32x4*)(L + O_NKK + o + 4);
            const f32x4 b0 = *(const LAS f32x4*)(L + O_BV + o), b1 = *(const LAS f32x4*)(L + O_BV + o + 4);
            const f32x4 q0 = *(const LAS f32x4*)(L + O_KP + o), q1 = *(const LAS f32x4*)(L + O_KP + o + 4);
            const f32x4 r0 = *(const LAS f32x4*)(L + O_RR + o), r1 = *(const LAS f32x4*)(L + O_RR + o + 4);
            const float vi = (s & 3) == 0 ? vq.x : (s & 3) == 1 ? vq.y : (s & 3) == 2 ? vq.z : vq.w;
            f32x2 a2 = S2[0] * (f32x2){n0.x, n0.y};
            a2 += S2[1] * (f32x2){n0.z, n0.w}; a2 += S2[2] * (f32x2){n1.x, n1.y}; a2 += S2[3] * (f32x2){n1.z, n1.w};
            const float sa = red8(a2.x + a2.y);
            const f32x2 sa2 = {sa, sa}, vi2 = {vi, vi};
            S2[0] += (f32x2){b0.x, b0.y} * sa2; S2[0] += (f32x2){q0.x, q0.y} * vi2;
            S2[1] += (f32x2){b0.z, b0.w} * sa2; S2[1] += (f32x2){q0.z, q0.w} * vi2;
            S2[2] += (f32x2){b1.x, b1.y} * sa2; S2[2] += (f32x2){q1.x, q1.y} * vi2;
            S2[3] += (f32x2){b1.z, b1.w} * sa2; S2[3] += (f32x2){q1.z, q1.w} * vi2;
            f32x2 y2 = S2[0] * (f32x2){r0.x, r0.y};
            y2 += S2[1] * (f32x2){r0.z, r0.w}; y2 += S2[2] * (f32x2){r1.x, r1.y}; y2 += S2[3] * (f32x2){r1.z, r1.w};
            const float y = red8(y2.x + y2.y);
            if (c == 0) L[O_YB + s * 64 + i] = y;
        }
        { const f32x4 g0 = *(const LAS f32x4*)(L + O_GAM + 8 * c), g1 = *(const LAS f32x4*)(L + O_GAM + 8 * c + 4);
          S2[0] *= (f32x2){g0.x, g0.y}; S2[1] *= (f32x2){g0.z, g0.w}; S2[2] *= (f32x2){g1.x, g1.y}; S2[3] *= (f32x2){g1.z, g1.w}; }
        __syncthreads();
        {
            const int o = ps * 64 + pj;
            const f32x4 y4 = *(const LAS f32x4*)(L + O_YB + o), v4 = *(const LAS f32x4*)(L + O_VV + o), g4 = *(const LAS f32x4*)(L + O_GG + o);
            const float bon = L[O_BON + ps];
            const float mu = sum16((y4.x + y4.y) + (y4.z + y4.w)) * (1.f / 64.f);
            const f32x4 d = y4 - mu;
            const float var = sum16((d.x * d.x + d.y * d.y) + (d.z * d.z + d.w * d.w)) * (1.f / 64.f);
            const float rstd = 1.0f / sqrtf(var + 64e-5f);
            const f32x4 out = (d * rstd * lg4 + lb4 + v4 * bon) * g4;
            u32x2 w; w.x = pk_bf16(out.x, out.y); w.y = pk_bf16(out.z, out.w);
            *(u32x2*)(YG + (rowb + (size_t)chk * CH + ps) * D_ + hc) = w;
        }
    }
    __syncthreads();
#undef SCAN_LOAD
}
}


#define XB_TMO      128
#define XB_XCNT(j)  (256  + 64 * (j))
#define XB_XSUB(j)  (1280 + 64 * (j))
#define XB_XGEN(j)  (2304 + 64 * (j))
#define XB_TOP      3328
#define XB_TOPGEN   3392
#define XCD_BAR_WORDS 3456
#define XB_SPIN_CAP (1u << 18)
constexpr size_t WS_CTL = 500 * MiB, CTL_BYTES = 16384;
constexpr int LDS_MISC_OFF = LDS_BYTES - 64;
__device__ __forceinline__ unsigned xb_ld(unsigned* p)              { return __hip_atomic_load(p, __ATOMIC_RELAXED, __HIP_MEMORY_SCOPE_AGENT); }
__device__ __forceinline__ unsigned xb_add(unsigned* p, unsigned v) { return __hip_atomic_fetch_add(p, v, __ATOMIC_RELAXED, __HIP_MEMORY_SCOPE_AGENT); }
__device__ __forceinline__ unsigned xb_xcc_id() { return (unsigned)__builtin_amdgcn_s_getreg((3 << 11) | 20) & 0xFu; }
#define XB_SPIN(cond, bar) do { unsigned _sp = 0; while (cond) { __builtin_amdgcn_s_sleep(1); \
    if ((++_sp & 255u) == 0u) { if (xb_ld(&(bar)[XB_TMO])) break; if (_sp > XB_SPIN_CAP) { atomicAdd(&(bar)[XB_TMO], 1u); break; } } } } while (0)
struct XcdBarrier { unsigned* bar; unsigned x; volatile LAS unsigned* st; };
__device__ __forceinline__ XcdBarrier xcd_barrier_post(unsigned* bar, volatile LAS unsigned* st) {
    XcdBarrier b; b.bar = bar; b.x = xb_xcc_id(); b.st = st;
    if (threadIdx.x == 0) (void)xb_add(&bar[XB_XCNT(b.x)], 1u);
    return b;
}
__device__ __forceinline__ void xcd_barrier_complete(unsigned* bar, unsigned x, unsigned& nloc, unsigned& nx) {
    const unsigned G = gridDim.x * gridDim.y * gridDim.z;
    unsigned sum, cnt, mine, sp = 0u;
    for (;;) {
        sum = 0u; cnt = 0u; mine = 0u;
#pragma unroll
        for (unsigned j = 0; j < 16; ++j) { const unsigned c = xb_ld(&bar[XB_XCNT(j)]); sum += c; cnt += (c > 0u) ? 1u : 0u; mine = (j == x) ? c : mine; }
        if (sum == G) break;
        __builtin_amdgcn_s_sleep(1);
        if ((++sp & 255u) == 0u) { if (xb_ld(&bar[XB_TMO])) break; if (sp > XB_SPIN_CAP) { atomicAdd(&bar[XB_TMO], 1u); break; } }
    }
    nloc = mine > 0u ? mine : 1u; nx = cnt > 0u ? cnt : 1u;
}
__device__ __forceinline__ void xcd_barrier(const XcdBarrier& b) {
    asm volatile("s_waitcnt vmcnt(0)" ::: "memory");
    __syncthreads();
    if (threadIdx.x == 0) {
        unsigned* bar = b.bar;
        __builtin_amdgcn_s_waitcnt(0);
        unsigned nloc = b.st[0], nx = b.st[1];
        if (nloc == 0u) { xcd_barrier_complete(bar, b.x, nloc, nx); b.st[0] = nloc; b.st[1] = nx; }
        const unsigned old = xb_add(&bar[XB_XSUB(b.x)], 1u);
        const unsigned gen = old / nloc;
        if (old + 1u == (gen + 1u) * nloc) {
            __builtin_amdgcn_fence(__ATOMIC_RELEASE, "agent");
            asm volatile("s_waitcnt vmcnt(0)" ::: "memory");
            const unsigned og = xb_add(&bar[XB_TOP], 1u);
            const unsigned tg = og / nx;
            if (og + 1u == (tg + 1u) * nx) xb_add(&bar[XB_TOPGEN], 1u);
            else XB_SPIN(xb_ld(&bar[XB_TOPGEN]) == tg, bar);
            __builtin_amdgcn_fence(__ATOMIC_ACQUIRE, "agent");
            xb_add(&bar[XB_XGEN(b.x)], 1u);
            asm volatile("s_waitcnt vmcnt(0)" ::: "memory");
        } else {
            XB_SPIN(xb_ld(&bar[XB_XGEN(b.x)]) == gen, bar);
            __builtin_amdgcn_fence(__ATOMIC_ACQUIRE, "agent");
            asm volatile("s_waitcnt vmcnt(0)" ::: "memory");
        }
    }
    __syncthreads();
}

__device__ __forceinline__ int fresh_lane() { int t = threadIdx.x; asm volatile("" : "+v"(t)); return t & 63; }
#ifndef PHMASK
#define PHMASK 0xFFFF
#endif
#define EN(n) (((PHMASK) >> (n)) & 1)
constexpr int N_PHASES = 22;
__global__ void __launch_bounds__(512, 2) mega_fwd(Params p) {
    extern __shared__ __attribute__((aligned(16))) unsigned char smem[];
    LAS unsigned char* lds = (LAS unsigned char*)smem;
    __builtin_assume(__builtin_amdgcn_workitem_id_y() == 0); __builtin_assume(__builtin_amdgcn_workitem_id_z() == 0);
    cg::grid_group grid = cg::this_grid();
    const int tid = threadIdx.x, wave = __builtin_amdgcn_readfirstlane(tid >> 6);
    const int G = gridDim.x, bx = blockIdx.x;
    const int vcu = (G % 8 == 0) ? (bx % 8) * (G / 8) + bx / 8 : bx;
    const int gw = vcu * 8 + wave, NGW = G * 8;
    unsigned char* ws = p.ws;
    bf16_t* X = (bf16_t*)((unsigned char*)p.out + 64 * MiB);
    if (tid < 16) ((volatile LAS unsigned*)(lds + LDS_MISC_OFF))[tid] = 0u;
    __syncthreads();
    if (bx == 0) for (int i = tid; i < (int)(CTL_BYTES / 4); i += 512) __hip_atomic_store((unsigned*)(ws + WS_CTL) + i, 0u, __ATOMIC_RELAXED, __HIP_MEMORY_SCOPE_AGENT);
    XcdBarrier xbar; xbar.bar = (unsigned*)(ws + WS_CTL); xbar.x = xb_xcc_id(); xbar.st = (volatile LAS unsigned*)(lds + LDS_MISC_OFF);
    bf16_t* XN = (bf16_t*)(ws + WS_XN);
    const int lo = p.ph_lo, hi = p.ph_hi;
    int ph = 0;
#ifndef PROBE_MASK
#define PROBE_MASK 0ull
#endif
    unsigned long long t_acc = 0ull, t_ph = 0ull;
    if (PROBE_MASK) t_ph = __builtin_amdgcn_s_memrealtime();
#define IN_PH() (lo <= ph && ph < hi)
#define END_PH() do { if (lo <= ph && ph + 1 < hi) { if (ph == 0) { grid.sync(); if (tid == 0) (void)xb_add(&xbar.bar[XB_XCNT(xbar.x)], 1u); } else xcd_barrier(xbar); } \
        if (PROBE_MASK) { const unsigned long long tn_ = __builtin_amdgcn_s_memrealtime(); if ((PROBE_MASK >> ph) & 1ull) t_acc += tn_ - t_ph; t_ph = tn_; } ++ph; } while (0)
#define GEMM_RUN(EpiT, Ev, Aop, Bop, M_, N_, K_, lda_, ldb_) do { pg8::Gemm g_{(const bf16_t*)(Aop), (const bf16_t*)(Bop), (M_), (N_), (K_), (lda_), (ldb_), (const bf16_t*)(Aop), 1 << 28}; pg8::StaticOrder S_o; S_o.init((M_), (N_), G, bx); \
        pg8::gemm_phase<EpiT>(lds, g_, S_o, Ev); } while (0)

    float* SS = (float*)(ws + WS_SS);
#define FFN_GU(f_, A_, ss_) do { if (IN_PH() && EN(2)) { pg8::EpiPair<0> E{(bf16_t*)(ws + WS_HID), FF_, 1 << 30, nullptr, 0, (ss_), (LAS float*)(lds + 131072)}; \
        GEMM_RUN(pg8::EpiPair<0>, E, (A_), ws + WS_FFN + (f_) * FFN_STRIDE, T_, 2 * FF_, D_, D_, D_); } END_PH(); } while (0)
#define FFN_DN(f_, BF32_, ST_, base_) do { if (IN_PH() && EN(3)) { pg8::EpiRes<BF32_, ST_> E{(const void*)(base_), X, 0.5f, SS}; \
        GEMM_RUN(pg8::EpiRes<BF32_ _C_ ST_>, E, ws + WS_HID, ws + WS_FFN + (f_) * FFN_STRIDE + FFN_DN_OFF, T_, D_, FF_, FF_, FF_); } END_PH(); } while (0)
#define _C_ ,

    if (IN_PH()) {
        if (EN(0)) weights_phase(p, lds, gw, NGW, wave, fresh_lane());
        if (EN(1)) norm_phase(p.in[0], p.in[2], XN, gw, NGW, fresh_lane());
    }
    END_PH();
    FFN_GU(0, XN, (const float*)nullptr);
    FFN_DN(0, true, true, p.in[0]);
    if (IN_PH() && EN(4)) { pg8::EpiPair<1> E{(bf16_t*)(ws + WS_U), D_, 8, (bf16_t*)(ws + WS_ZL), 1024, SS, (LAS float*)(lds + 131072)}; GEMM_RUN(pg8::EpiPair<1>, E, X, ws + WS_WIN, T_, 3072, D_, D_, D_); }
    END_PH();
    if (IN_PH()) {
        if (EN(5)) conv_phase(lds, (const bf16_t*)(ws + WS_U), p.in[8], p.in[9], p.in[10], p.in[11], (bf16_t*)(ws + WS_CONV), vcu, G);
        if (EN(6)) latents_phase((bf16_t*)(ws + WS_ZL), p.in[12], p.in[14], (const int*)p.in[1], (bf16_t*)(ws + WS_KPE), (f32x2*)(ws + WS_ROPE), gw, NGW, fresh_lane());
    }
    END_PH();
    if (IN_PH() && EN(7)) {
        { pg8::EpiStore E{(bf16_t*)(ws + WS_Q), 1536}; GEMM_RUN(pg8::EpiStore, E, ws + WS_ZL, ws + WS_WUQ, T_, 1536, 512, 1024, 512); }
        { pg8::EpiStoreT<1> E{(bf16_t*)(ws + WS_KN), 1024}; GEMM_RUN(pg8::EpiStoreT<1>, E, ws + WS_ZL + 512 * 2, ws + WS_WKN, T_, 1024, 256, 1024, 256); }
        { pg8::EpiStoreT<2> E{(bf16_t*)(ws + WS_VT), T_}; GEMM_RUN(pg8::EpiStoreT<2>, E, ws + WS_WVT, ws + WS_ZL + 512 * 2, 1024, T_, 256, 256, 1024); }
    }
    END_PH();
    if (IN_PH() && EN(8)) {
        for (int v = vcu; v < 256; v += G) {
            const int bh = v >> 1, hf = v & 1;
#pragma unroll 1
            for (int i = 0; i < 4; ++i) {
                const int qb = hf == 0 ? (i == 0 ? 7 : i == 1 ? 0 : i == 2 ? 4 : 3) : (i == 0 ? 6 : i == 1 ? 1 : i == 2 ? 5 : 2);
                att::attn_unit(lds, bh >> 3, bh & 7, qb, (const bf16_t*)(ws + WS_Q), (const bf16_t*)(ws + WS_KN), (const bf16_t*)(ws + WS_KPE), (const bf16_t*)(ws + WS_VT), (const f32x2*)(ws + WS_ROPE), (bf16_t*)(ws + WS_ATT), ws);
            }
        }
    }
    END_PH();
    if (IN_PH() && EN(3)) {
        pg8::Gemm g_{(const bf16_t*)(ws + WS_CONV), (const bf16_t*)(ws + WS_WOUT), T_, D_, 2048, 1024, 2048, (const bf16_t*)(ws + WS_ATT), 16};
        pg8::StaticOrder S_o; S_o.init(T_, D_, G, bx);
        pg8::EpiRes<false, true> E{(const void*)X, X, 1.0f, SS};
        pg8::gemm_phase<pg8::EpiRes<false, true>>(lds, g_, S_o, E);
    }
    END_PH();
    FFN_GU(1, X, (const float*)(SS));
    FFN_DN(1, false, true, X);
    FFN_GU(2, X, (const float*)(SS));
    FFN_DN(2, false, false, X);
    {
        const float* mu = p.in[18];
        if (IN_PH() && EN(9)) mix_phase(X, p.in[17], mu, mu + 2 * D_, mu + 3 * D_, (bf16_t*)(ws + WS_XR), (size_t)T_ * D_, D_, gw, NGW, fresh_lane());
        END_PH();
        if (IN_PH() && EN(7)) {
            { pg8::EpiStore E{(bf16_t*)(ws + WS_R), D_}; GEMM_RUN(pg8::EpiStore, E, ws + WS_XR, ws + WS_WR, T_, D_, D_, D_, D_); }
            { pg8::EpiStore E{(bf16_t*)(ws + WS_K), D_}; GEMM_RUN(pg8::EpiStore, E, ws + WS_XK, ws + WS_WK, T_, D_, D_, D_, D_); }
            { pg8::EpiStore E{(bf16_t*)(ws + WS_V), D_}; GEMM_RUN(pg8::EpiStore, E, ws + WS_XV, ws + WS_WV, T_, D_, D_, D_, D_); }
        }
        END_PH();
        if (IN_PH() && EN(9)) mix_phase(X, p.in[17], mu + 1 * D_, mu + 4 * D_, mu + 5 * D_, (bf16_t*)(ws + WS_XWAG), (size_t)T_ * D_, D_, gw, NGW, fresh_lane());
        END_PH();
        if (IN_PH() && EN(10)) { pg8::EpiL1 E{(bf16_t*)(ws + WS_L1)}; GEMM_RUN(pg8::EpiL1, E, ws + WS_XWAG, ws + WS_WL1, 3 * T_, 256, D_, D_, D_); }
        END_PH();
        if (IN_PH() && EN(11)) { pg8::EpiL2 E{(bf16_t*)(ws + WS_WAG), p.in[23], p.in[26]}; GEMM_RUN(pg8::EpiL2, E, ws + WS_L1, ws + WS_WL2, T_, 3072, 256, 256, 256); }
        END_PH();
        if (IN_PH() && EN(12)) {
            for (int v = vcu; v < 256; v += G)
                scan::scan_unit(lds, v >> 4, v & 15, (const bf16_t*)(ws + WS_R), (const bf16_t*)(ws + WS_K), (const bf16_t*)(ws + WS_V), (const bf16_t*)(ws + WS_WAG),
                                p.in[31], p.in[32], p.in[33], p.in[34], p.in[35], (bf16_t*)(ws + WS_R));
        }
        END_PH();
        if (IN_PH() && EN(3)) { pg8::EpiRes<false, true> E{(const void*)X, X, 1.0f, SS}; GEMM_RUN(pg8::EpiRes<false _C_ true>, E, ws + WS_R, ws + WS_WO, T_, D_, D_, D_, D_); }
        END_PH();
    }
    FFN_GU(3, X, (const float*)(SS));
    if (IN_PH() && EN(3)) { pg8::EpiRes<false, false> E{(const void*)X, (bf16_t*)(ws + WS_XN), 0.5f, SS};
        GEMM_RUN(pg8::EpiRes<false _C_ false>, E, ws + WS_HID, ws + WS_FFN + 3 * FFN_STRIDE + FFN_DN_OFF, T_, D_, FF_, FF_, FF_); }
    END_PH();
    if (IN_PH() && EN(13)) final_norm_phase((const bf16_t*)(ws + WS_XN), 0, p.out, p.in[36], 0, T_, nullptr, nullptr, 0, 0, gw, NGW, fresh_lane());
    END_PH();
    if (PROBE_MASK) {
        unsigned* cw = (unsigned*)(ws + 501 * MiB);
#ifdef PROBE_SYNCS
        { const unsigned long long t0_ = __builtin_amdgcn_s_memrealtime(); for (int q = 0; q < 20; ++q) grid.sync(); t_acc = __builtin_amdgcn_s_memrealtime() - t0_; }
#endif
        if (bx == 0 && tid == 0) __hip_atomic_store(cw, (unsigned)t_acc, __ATOMIC_RELAXED, __HIP_MEMORY_SCOPE_AGENT);
        grid.sync();
        const unsigned ticks = __hip_atomic_load(cw, __ATOMIC_RELAXED, __HIP_MEMORY_SCOPE_AGENT);
        const float dt_us = (float)ticks * 0.01f;
        const float delta = sqrtf(fminf(2e-6f * dt_us, 0.0225f));
        for (int i = bx * 512 + tid; i < (1 << 20); i += G * 512) p.out[i] += delta;
    }
}

static void add_job(Params& p, const float* src, bf16_t* dst, int ldsrc, int c0, int sstride, int G, int lddst, int r0, int dstride, int dk0, int Kc, int Nc, float scale, const float* kscale = nullptr) {
    if (p.njobs >= NJOBS) { fprintf(stderr, "too many jobs\n"); return; }
    Job& j = p.jobs[p.njobs++];
    j.src = src; j.dst = dst; j.kscale = kscale; j.ldsrc = ldsrc; j.c0 = c0; j.sstride = sstride; j.G = G; j.lddst = lddst; j.r0 = r0; j.dstride = dstride; j.dk0 = dk0; j.Kc = Kc; j.Nc = Nc; j.scale = scale;
    j.item0 = p.nitems; p.nitems += (Kc / 64) * (Nc / 32);
}

extern "C" void kernel_launch(void* const* d_in, const int* in_sizes, int n_in, void* d_out, int out_size, void* d_ws, size_t ws_size, hipStream_t stream) {
    static int grid = 0;
    if (grid == 0) {
        if (n_in != 37 || ws_size < WS_END) { fprintf(stderr, "kernel_launch: unexpected n_in %d / ws %zu\n", n_in, ws_size); grid = -1; return; }
        int dev = 0, cus = 0, per_cu = 0;
        (void)hipGetDevice(&dev); (void)hipDeviceGetAttribute(&cus, hipDeviceAttributeMultiprocessorCount, dev);
        if (hipFuncSetAttribute((const void*)mega_fwd, hipFuncAttributeMaxDynamicSharedMemorySize, LDS_BYTES) != hipSuccess) { fprintf(stderr, "hipFuncSetAttribute failed\n"); grid = -1; return; }
        if (hipOccupancyMaxActiveBlocksPerMultiprocessor(&per_cu, (const void*)mega_fwd, 512, LDS_BYTES) != hipSuccess || per_cu < 1) { fprintf(stderr, "occupancy query: %d\n", per_cu); per_cu = 1; }
        (void)hipGetLastError();
        grid = cus * 1;
        if (grid > 256) grid = 256;
    }
    if (grid < 0) return;
    Params p; memset(&p, 0, sizeof(p));
    for (int i = 0; i < 37; ++i) p.in[i] = (const float*)d_in[i];
    p.out = (float*)d_out; p.ws = (unsigned char*)d_ws;
    unsigned char* ws = (unsigned char*)d_ws;
    for (int f = 0; f < 4; ++f) {
        const float* wg = p.in[3] + (size_t)f * D_ * FF_; const float* wu = p.in[4] + (size_t)f * D_ * FF_; const float* wd = p.in[5] + (size_t)f * FF_ * D_;
        bf16_t* gu = (bf16_t*)(ws + WS_FFN + f * FFN_STRIDE); bf16_t* dn = (bf16_t*)(ws + WS_FFN + f * FFN_STRIDE + FFN_DN_OFF);
        const float* ng = f == 0 ? nullptr : p.in[2] + (size_t)f * D_;
        add_job(p, wg, gu, FF_, 0, 128, 128, D_, 0, 256, 0, D_, FF_, 1.f, ng);
        add_job(p, wu, gu, FF_, 0, 128, 128, D_, 128, 256, 0, D_, FF_, 1.f, ng);
        add_job(p, wd, dn, D_, 0, 0, D_, FF_, 0, 0, 0, FF_, D_, 1.f);
    }
    { bf16_t* w = (bf16_t*)(ws + WS_WIN);
      add_job(p, p.in[7], w, 2880, 0, 128, 128, D_, 0, 256, 0, D_, 1024, 1.f, p.in[6]);
      add_job(p, p.in[7], w, 2880, 1024, 128, 128, D_, 128, 256, 0, D_, 1024, 1.f, p.in[6]);
      add_job(p, p.in[7], w, 2880, 2048, 0, 832, D_, 2048, 0, 0, D_, 832, 1.f, p.in[6]);
      add_job(p, nullptr, w, 0, 0, 0, 192, D_, 2880, 0, 0, D_, 192, 1.f); }
    add_job(p, p.in[13], (bf16_t*)(ws + WS_WUQ), 1536, 0, 0, 1536, 512, 0, 0, 0, 512, 1536, 0.07216878364870322f * 1.4426950408889634f);
    add_job(p, p.in[15], (bf16_t*)(ws + WS_WKN), 2048, 0, 256, 128, 256, 0, 128, 0, 256, 1024, 1.f);
    add_job(p, p.in[15], (bf16_t*)(ws + WS_WVT), 2048, 128, 256, 128, 256, 0, 128, 0, 256, 1024, 1.f);
    add_job(p, p.in[16], (bf16_t*)(ws + WS_WOUT), 1024, 0, 0, 1024, 2048, 0, 0, 0, 2048, 1024, 1.f);
    add_job(p, p.in[19], (bf16_t*)(ws + WS_WR), 1024, 0, 0, 1024, 1024, 0, 0, 0, 1024, 1024, 1.f);
    add_job(p, p.in[20], (bf16_t*)(ws + WS_WK), 1024, 0, 0, 1024, 1024, 0, 0, 0, 1024, 1024, 1.f);
    add_job(p, p.in[21], (bf16_t*)(ws + WS_WV), 1024, 0, 0, 1024, 1024, 0, 0, 0, 1024, 1024, 1.f);
    add_job(p, p.in[22], (bf16_t*)(ws + WS_WO), 1024, 0, 0, 1024, 1024, 0, 0, 0, 1024, 1024, 1.f);
    { bf16_t* w = (bf16_t*)(ws + WS_WL1);
      add_job(p, p.in[24], w, 64, 0, 0, 64, 1024, 0, 0, 0, 1024, 64, 1.f);
      add_job(p, p.in[27], w, 64, 0, 0, 64, 1024, 64, 0, 0, 1024, 64, 1.f);
      add_job(p, p.in[29], w, 128, 0, 0, 128, 1024, 128, 0, 0, 1024, 128, 1.f); }
    { bf16_t* w = (bf16_t*)(ws + WS_WL2);
      add_job(p, p.in[25], w, 1024, 0, 0, 1024, 256, 0, 0, 0, 64, 1024, 1.f);
      add_job(p, p.in[28], w, 1024, 0, 0, 1024, 256, 1024, 0, 64, 64, 1024, 1.f);
      add_job(p, p.in[30], w, 1024, 0, 0, 1024, 256, 2048, 0, 128, 128, 1024, 1.f);
      add_job(p, nullptr, w, 0, 0, 0, 1024, 256, 0, 0, 64, 192, 1024, 1.f);
      add_job(p, nullptr, w, 0, 0, 0, 1024, 256, 1024, 0, 0, 64, 1024, 1.f);
      add_job(p, nullptr, w, 0, 0, 0, 1024, 256, 1024, 0, 128, 128, 1024, 1.f);
      add_job(p, nullptr, w, 0, 0, 0, 1024, 256, 2048, 0, 0, 128, 1024, 1.f); }
    p.ph_lo = 0; p.ph_hi = N_PHASES;
    void* args[] = {&p};
    hipError_t e = hipLaunchCooperativeKernel((const void*)mega_fwd, dim3(grid), dim3(512), args, LDS_BYTES, stream);
    if (e != hipSuccess) fprintf(stderr, "cooperative launch failed: %s (grid %d)\n", hipGetErrorString(e), grid);
}
```

```cpp
#include <hip/hip_runtime.h>
#include <hip/hip_cooperative_groups.h>
#include <cstdio>
#include <cstdint>
#include <cstring>
namespace cg = cooperative_groups;

#define LAS __attribute__((address_space(3)))
typedef unsigned short bf16_t;
typedef short bf16x8 __attribute__((ext_vector_type(8)));
typedef float f32x4 __attribute__((ext_vector_type(4)));
typedef float f32x2 __attribute__((ext_vector_type(2)));
typedef float f32x16 __attribute__((ext_vector_type(16)));
typedef unsigned u32x4 __attribute__((ext_vector_type(4)));
typedef unsigned u32x2 __attribute__((ext_vector_type(2)));

constexpr int T_ = 32768, D_ = 1024, FF_ = 2816, S_ = 2048, NB_ = 16;
constexpr float LOG2E = 1.4426950408889634f;
constexpr size_t MiB = 1u << 20;
constexpr size_t WS_FFN = 0;
constexpr size_t FFN_STRIDE = 16 * MiB + MiB / 2, FFN_DN_OFF = 11 * MiB;
constexpr size_t WS_WIN = 66 * MiB, WS_WUQ = 72 * MiB, WS_WKN = 73 * MiB + MiB / 2, WS_WVT = 74 * MiB, WS_WOUT = 74 * MiB + MiB / 2;
constexpr size_t WS_WR = 78 * MiB + MiB / 2, WS_WK = 80 * MiB + MiB / 2, WS_WV = 82 * MiB + MiB / 2, WS_WO = 84 * MiB + MiB / 2;
constexpr size_t WS_WL1 = 86 * MiB + MiB / 2, WS_WL2 = 88 * MiB;
constexpr size_t WS_XN = 96 * MiB;
constexpr size_t WS_VT = 96 * MiB;
constexpr size_t WS_HID = 160 * MiB;
constexpr size_t WS_U = 160 * MiB;
constexpr size_t WS_Q = 160 * MiB;
constexpr size_t WS_ZL = 288 * MiB;
constexpr size_t WS_ATT = 288 * MiB;
constexpr size_t WS_CONV = 352 * MiB;
constexpr size_t WS_KN = 416 * MiB;
constexpr size_t WS_KPE = 480 * MiB;
constexpr size_t WS_ROPE = 484 * MiB;
constexpr size_t WS_R = 96 * MiB, WS_K = 160 * MiB, WS_V = 224 * MiB;
constexpr size_t WS_XR = 288 * MiB, WS_XK = 352 * MiB, WS_XV = 416 * MiB;
constexpr size_t WS_XWAG = 96 * MiB;
constexpr size_t WS_WAG = 288 * MiB;
constexpr size_t WS_L1 = 480 * MiB;
constexpr size_t WS_XB3 = 336 * MiB;
constexpr size_t WS_SS = 502 * MiB;
constexpr size_t WS_END = 512 * MiB;

constexpr int LDS_BYTES = 147456;
constexpr int NJOBS = 40;

struct Job { const float* src; bf16_t* dst; const float* kscale; int ldsrc, c0, sstride, G, lddst, r0, dstride, dk0, Kc, Nc, item0; float scale; };
struct Params {
    const float* in[37];
    float* out; unsigned char* ws;
    int njobs, nitems, ph_lo, ph_hi;
    Job jobs[NJOBS];
};

__device__ __forceinline__ unsigned pk_bf16(float lo, float hi) { typedef __bf16 b2 __attribute__((ext_vector_type(2))); f32x2 v = {lo, hi}; b2 b = __builtin_convertvector(v, b2); return __builtin_bit_cast(unsigned, b); }
__device__ __forceinline__ unsigned pk_f16(float lo, float hi) { typedef _Float16 h2 __attribute__((ext_vector_type(2))); h2 b = {(_Float16)lo, (_Float16)hi}; return __builtin_bit_cast(unsigned, b); }
__device__ __forceinline__ float bf_lo(unsigned u) { return __uint_as_float(u << 16); }
__device__ __forceinline__ float bf_hi(unsigned u) { return __uint_as_float(u & 0xffff0000u); }
__device__ __forceinline__ float h_lo(unsigned u) { typedef _Float16 h2 __attribute__((ext_vector_type(2))); h2 b = __builtin_bit_cast(h2, u); return (float)b[0]; }
__device__ __forceinline__ float h_hi(unsigned u) { typedef _Float16 h2 __attribute__((ext_vector_type(2))); h2 b = __builtin_bit_cast(h2, u); return (float)b[1]; }
__device__ __forceinline__ float fexp2(float x) { return __builtin_amdgcn_exp2f(x); }
__device__ __forceinline__ float frcp(float x) { return __builtin_amdgcn_rcpf(x); }
__device__ __forceinline__ float sigmoidf_(float x) { return frcp(1.0f + fexp2(-x * LOG2E)); }
__device__ __forceinline__ float wave_sum(float v) {
#pragma unroll
    for (int o = 1; o < 64; o <<= 1) v += __shfl_xor(v, o);
    return v;
}
__device__ __forceinline__ float sum16(float v) {
#pragma unroll
    for (int o = 1; o < 16; o <<= 1) v += __shfl_xor(v, o);
    return v;
}
#define LDS_WAIT() asm volatile("s_waitcnt lgkmcnt(0)" ::: "memory")

namespace pg8 {
constexpr int BM = 256, BK = 64, HALF = 128, HTB = HALF * BK * 2, STAGE_BYTES = 8 * HTB, NXCD = 8, WGM = 8;
__host__ __device__ __forceinline__ int lds_byte(int r, int c) { const int st = (r >> 4) * 2 + (c >> 5), rr = r & 15, cc = c & 31, ob = rr * 64 + cc * 2; return st * 1024 + (ob ^ (((ob >> 9) & 1) << 5)); }
__host__ __device__ __forceinline__ void stage_rc(int b, int& R, int& C) { const int st = b / 1024, sb = b % 1024, swz = sb ^ (((sb >> 9) & 1) << 5); R = (st >> 1) * 16 + swz / 64; C = (st & 1) * 32 + (swz % 64) / 2; }
__host__ __device__ __forceinline__ int perm32(int rho) { const int n = rho >> 4, i = rho & 15; return 8 * (i >> 2) + 4 * n + (i & 3); }

struct Unit { int pm, pn; };
struct Gemm { const bf16_t* A; const bf16_t* Bt; int M, N, K, lda, ldb; const bf16_t* A2; int ksp; };

struct StaticOrder {
    int nM, nN, nwg, G, c;
    __device__ void init(int M, int N, int G_, int c_) { nM = M / BM; nN = N / BM; nwg = nM * nN; G = G_; c = c_; }
    __device__ bool next(int i, Unit& u) const {
        const long L = (long)i * G + c; if (L >= nwg) return false;
        int wgid = (int)L; { const int q = nwg / NXCD, r = nwg % NXCD, xcd = wgid % NXCD, off = wgid / NXCD; wgid = (xcd < r ? xcd * (q + 1) : r * (q + 1) + (xcd - r) * q) + off; }
        const int nig = WGM * nN, gid = wgid / nig, fm = gid * WGM, gsz = (nM - fm) < WGM ? (nM - fm) : WGM;
        u.pm = fm + ((wgid % nig) % gsz); u.pn = (wgid % nig) / gsz; return true;
    }
};

typedef f32x4 Acc[2][2][4][2];

template <int MODE> struct EpiStoreT {
    bf16_t* O; int ldc;
    __device__ __forceinline__ void operator()(const Acc& acc, const Unit& u, int wr, int wc, int fr, int fq) const {
        const int row0 = u.pm * BM + wr * 64 + fr, col0 = u.pn * BM + wc * 32 + 8 * fq;
#pragma unroll
        for (int ai = 0; ai < 2; ++ai)
#pragma unroll
            for (int m = 0; m < 4; ++m) { const int row = row0 + ai * HALF + m * 16;
#pragma unroll
                for (int bj = 0; bj < 2; ++bj) { const int col = col0 + bj * HALF; size_t idx;
                    if (MODE == 0) idx = (size_t)row * ldc + col;
                    else if (MODE == 1) idx = ((size_t)((row >> 11) * 8 + (col >> 7)) * 2048 + (row & 2047)) * 128 + (col & 127);
                    else idx = ((((size_t)((col >> 11) * 8 + (row >> 7))) * 32 + ((col & 2047) >> 6)) * 128 + (row & 127)) * 64 + (col & 63);
                    const f32x4 v0 = acc[ai][bj][m][0], v1 = acc[ai][bj][m][1];
                    u32x4 w; w.x = pk_bf16(v0[0], v0[1]); w.y = pk_bf16(v0[2], v0[3]); w.z = pk_bf16(v1[0], v1[1]); w.w = pk_bf16(v1[2], v1[3]);
                    *(u32x4*)(O + idx) = w; } }
    }
};
typedef EpiStoreT<0> EpiStore;
__device__ __forceinline__ float row_rstd(const float* ss, int row) {
    if (!ss) return 1.0f;
    const f32x4* q = (const f32x4*)(ss + (size_t)row * 16);
    const f32x4 a = q[0], b = q[1], c = q[2], d = q[3];
    const float t = ((a.x + a.y) + (a.z + a.w)) + ((b.x + b.y) + (b.z + b.w)) + ((c.x + c.y) + (c.z + c.w)) + ((d.x + d.y) + (d.z + d.w));
    return 1.0f / sqrtf(t * (1.f / D_) + 1e-6f);
}
template <int ACT> struct EpiPair {
    bf16_t* O; int ldc; int split_pn; bf16_t* O2; int ldc2; const float* ss; LAS float* tab;
    __device__ __forceinline__ void operator()(const Acc& acc, const Unit& u, int wr, int wc, int fr, int fq) const {
        const int row0 = u.pm * BM + wr * 64 + fr;
        if (ss) {
            int t2 = threadIdx.x; asm volatile("" : "+v"(t2));
            const f32x4* q = (const f32x4*)(ss + ((size_t)(u.pm * BM + (t2 >> 1)) * 16 + (t2 & 1) * 8));
            const f32x4 a = q[0], b = q[1];
            float t = ((a.x + a.y) + (a.z + a.w)) + ((b.x + b.y) + (b.z + b.w));
            t += __shfl_xor(t, 1);
            if ((t2 & 1) == 0) tab[t2 >> 1] = 1.0f / sqrtf(t * (1.f / D_) + 1e-6f);
            asm volatile("s_waitcnt lgkmcnt(0)" ::: "memory"); __builtin_amdgcn_s_barrier(); asm volatile("" ::: "memory");
        }
        const int trow0 = wr * 64 + fr;
        if (u.pn >= split_pn) {
            const int col0 = (u.pn - split_pn) * BM + wc * 32 + 8 * fq;
#pragma unroll
            for (int ai = 0; ai < 2; ++ai)
#pragma unroll
                for (int m = 0; m < 4; ++m) { const int row = row0 + ai * HALF + m * 16; bf16_t* rowp = O2 + (size_t)row * ldc2 + col0;
                    const float rs = ss ? tab[trow0 + ai * HALF + m * 16] : 1.0f;
#pragma unroll
                    for (int bj = 0; bj < 2; ++bj) { const f32x4 v0 = acc[ai][bj][m][0] * rs, v1 = acc[ai][bj][m][1] * rs;
                        u32x4 w; w.x = pk_bf16(v0[0], v0[1]); w.y = pk_bf16(v0[2], v0[3]); w.z = pk_bf16(v1[0], v1[1]); w.w = pk_bf16(v1[2], v1[3]);
                        *(u32x4*)(rowp + bj * HALF) = w; }
                    asm volatile("" ::: "memory"); }
            return;
        }
        const int col0 = u.pn * HALF + wc * 32 + 8 * fq;
#pragma unroll
        for (int ai = 0; ai < 2; ++ai)
#pragma unroll
            for (int m = 0; m < 4; ++m) { const int row = row0 + ai * HALF + m * 16; bf16_t* rowp = O + (size_t)row * ldc + col0;
                const float rs = ss ? tab[trow0 + ai * HALF + m * 16] : 1.0f;
                float r[8];
#pragma unroll
                for (int n = 0; n < 2; ++n)
#pragma unroll
                    for (int e = 0; e < 4; ++e) { const float p = acc[ai][0][m][n][e] * rs, q = acc[ai][1][m][n][e] * rs;
                        r[n * 4 + e] = (ACT == 0) ? p * sigmoidf_(p) * q : p * sigmoidf_(q); }
                u32x4 w; w.x = pk_bf16(r[0], r[1]); w.y = pk_bf16(r[2], r[3]); w.z = pk_bf16(r[4], r[5]); w.w = pk_bf16(r[6], r[7]);
                *(u32x4*)rowp = w; asm volatile("" ::: "memory"); }
    }
};
template <bool BASE_F32, bool STATS> struct EpiRes {
    const void* base; bf16_t* out; float scale; float* ss;
    __device__ __forceinline__ void operator()(const Acc& acc, const Unit& u, int wr, int wc, int fr, int fq) const {
        const int row0 = u.pm * BM + wr * 64 + fr, col0 = u.pn * BM + wc * 32 + 8 * fq;
        u32x4 cb0, cb1;
        if (!BASE_F32) { const bf16_t* bp = (const bf16_t*)base + (size_t)row0 * D_ + col0; cb0 = *(const u32x4*)bp; cb1 = *(const u32x4*)(bp + HALF); }
#pragma unroll
        for (int it = 0; it < 8; ++it) { const int ai = it >> 2, m = it & 3;
            const int row = row0 + ai * HALF + m * 16; const size_t off = (size_t)row * D_ + col0;
            u32x4 nb0, nb1;
            if (!BASE_F32 && it < 7) { const int nrow = row0 + ((it + 1) >> 2) * HALF + ((it + 1) & 3) * 16; const bf16_t* bp = (const bf16_t*)base + (size_t)nrow * D_ + col0; nb0 = *(const u32x4*)bp; nb1 = *(const u32x4*)(bp + HALF); }
            float sq = 0.f;
#pragma unroll
            for (int bj = 0; bj < 2; ++bj) {
                f32x4 b0, b1;
                if (BASE_F32) { b0 = *(const f32x4*)((const float*)base + off + bj * HALF); b1 = *(const f32x4*)((const float*)base + off + bj * HALF + 4); }
                else { const u32x4 cb = bj == 0 ? cb0 : cb1; b0 = (f32x4){bf_lo(cb.x), bf_hi(cb.x), bf_lo(cb.y), bf_hi(cb.y)}; b1 = (f32x4){bf_lo(cb.z), bf_hi(cb.z), bf_lo(cb.w), bf_hi(cb.w)}; }
                const f32x4 o0 = b0 + acc[ai][bj][m][0] * scale, o1 = b1 + acc[ai][bj][m][1] * scale;
                if (STATS) sq += (o0[0] * o0[0] + o0[1] * o0[1]) + (o0[2] * o0[2] + o0[3] * o0[3]) + (o1[0] * o1[0] + o1[1] * o1[1]) + (o1[2] * o1[2] + o1[3] * o1[3]);
                u32x4 w; w.x = pk_bf16(o0[0], o0[1]); w.y = pk_bf16(o0[2], o0[3]); w.z = pk_bf16(o1[0], o1[1]); w.w = pk_bf16(o1[2], o1[3]);
                *(u32x4*)(out + off + bj * HALF) = w; }
            if (STATS) { sq += __shfl_xor(sq, 16); sq += __shfl_xor(sq, 32);
                if (fq == 0) ss[(size_t)row * 16 + u.pn * 4 + wc] = sq; }
            asm volatile("" ::: "memory");
            if (!BASE_F32) { cb0 = nb0; cb1 = nb1; } }
    }
};
struct EpiL1 {
    bf16_t* O;
    __device__ __forceinline__ void operator()(const Acc& acc, const Unit& u, int wr, int wc, int fr, int fq) const {
        const int blk = u.pm >> 7;
        const int row0 = (u.pm & 127) * BM + wr * 64 + fr, col0 = wc * 32 + 8 * fq;
        if (blk == 2) {
#pragma unroll
            for (int ai = 0; ai < 2; ++ai)
#pragma unroll
                for (int m = 0; m < 4; ++m) { bf16_t* rowp = O + (size_t)(row0 + ai * HALF + m * 16) * 256 + col0 + HALF; float r[8];
#pragma unroll
                    for (int n = 0; n < 2; ++n)
#pragma unroll
                        for (int e = 0; e < 4; ++e) r[n * 4 + e] = sigmoidf_(acc[ai][1][m][n][e]);
                    u32x4 w; w.x = pk_bf16(r[0], r[1]); w.y = pk_bf16(r[2], r[3]); w.z = pk_bf16(r[4], r[5]); w.w = pk_bf16(r[6], r[7]);
                    *(u32x4*)rowp = w; asm volatile("" ::: "memory"); }
        } else if ((wc >> 1) == blk) {
#pragma unroll
            for (int ai = 0; ai < 2; ++ai)
#pragma unroll
                for (int m = 0; m < 4; ++m) { bf16_t* rowp = O + (size_t)(row0 + ai * HALF + m * 16) * 256 + col0; float r[8];
#pragma unroll
                    for (int n = 0; n < 2; ++n)
#pragma unroll
                        for (int e = 0; e < 4; ++e) { const float v = acc[ai][0][m][n][e];
                            r[n * 4 + e] = blk == 0 ? 1.0f - 2.0f * frcp(1.0f + fexp2(2.0f * LOG2E * v)) : v; }
                    u32x4 w; w.x = pk_bf16(r[0], r[1]); w.y = pk_bf16(r[2], r[3]); w.z = pk_bf16(r[4], r[5]); w.w = pk_bf16(r[6], r[7]);
                    *(u32x4*)rowp = w; asm volatile("" ::: "memory"); }
        }
    }
};
struct EpiL2 {
    bf16_t* O; const float* w0; const float* a0;
    __device__ __forceinline__ void operator()(const Acc& acc, const Unit& u, int wr, int wc, int fr, int fq) const {
        const int row0 = u.pm * BM + wr * 64 + fr, col0 = u.pn * BM + wc * 32 + 8 * fq;
        const int kind = u.pn >> 2;
        const float* bias = kind == 1 ? a0 : w0;
        const float bsel = kind < 2 ? 1.f : 0.f, csc = kind == 0 ? 0.6065306597126334f : 1.f;
        const int bcol0 = (u.pn & 3) * BM + wc * 32 + 8 * fq;
#pragma unroll
        for (int bj = 0; bj < 2; ++bj) {
            const f32x4 b0 = *(const f32x4*)(bias + bcol0 + bj * HALF) * bsel, b1 = *(const f32x4*)(bias + bcol0 + bj * HALF + 4) * bsel;
#pragma unroll
            for (int ai = 0; ai < 2; ++ai)
#pragma unroll
                for (int m = 0; m < 4; ++m) { bf16_t* rowp = O + (size_t)(row0 + ai * HALF + m * 16) * 3072 + col0 + bj * HALF;
                    float r[8];
#pragma unroll
                    for (int e = 0; e < 4; ++e) { r[e] = acc[ai][bj][m][0][e] + b0[e]; r[4 + e] = acc[ai][bj][m][1][e] + b1[e]; }
#pragma unroll
                    for (int e = 0; e < 8; ++e) { const float sg = csc * sigmoidf_(r[e]); r[e] = kind == 2 ? r[e] : sg; }
                    u32x4 w; w.x = pk_f16(r[0], r[1]); w.y = pk_f16(r[2], r[3]); w.z = pk_f16(r[4], r[5]); w.w = pk_f16(r[6], r[7]);
                    *(u32x4*)rowp = w; asm volatile("" ::: "memory"); }
        }
    }
};

template <class Epi>
__device__ __forceinline__ void gemm_phase(LAS unsigned char* lds, const Gemm g, const StaticOrder& S, const Epi& E) {
    const int tid = threadIdx.x, wid = __builtin_amdgcn_readfirstlane(tid >> 6), lane = tid & 63, wr = wid >> 2, wc = wid & 3, fr = lane & 15, fq = lane >> 4;
    const int K = g.K, nt = K / BK;
    unsigned voffA[2], voffB[2];
#pragma unroll
    for (int i = 0; i < 2; ++i) { int R, C; stage_rc(tid * 16 + i * 8192, R, C); const int Rb = (R & ~31) + perm32(R & 31);
        voffA[i] = (unsigned)(R * g.lda + C) * 2u; voffB[i] = (unsigned)(Rb * g.ldb + C) * 2u; }
    const size_t kstep = (size_t)(BK * 2);
    const size_t hstepA = (size_t)HALF * g.lda * 2, hstepB = (size_t)HALF * g.ldb * 2;
    const size_t tstepA = 2 * hstepA, tstepB = 2 * hstepB;
    const unsigned ldsw = (unsigned)wid * 1024u;
    const int aoff = lds_byte(wr * 64 + fr, fq * 8), boff = lds_byte(wc * 32 + fr, fq * 8);
#define PG8_SA(b, h) (((b) * 2 + (h)) * HTB)
#define PG8_SB(b, h) ((4 + (b) * 2 + (h)) * HTB)
#define PG8_STAGE(bufoff, gbase, voff) do { _Pragma("unroll") for (int _i = 0; _i < 2; ++_i) \
        __builtin_amdgcn_global_load_lds((const unsigned*)((const char*)(gbase) + (voff)[_i]), (LAS unsigned*)(lds + (bufoff) + ldsw + _i * 8192), 16, 0, 0); } while (0)
#define PG8_LDA(dst, b, h) do { _Pragma("unroll") for (int m = 0; m < 4; ++m) _Pragma("unroll") for (int k = 0; k < 2; ++k) dst[m][k] = *(const LAS bf16x8*)(lds + PG8_SA(b, h) + aoff + m * 2048 + k * 1024); } while (0)
#define PG8_LDB(dst, b, h) do { _Pragma("unroll") for (int n = 0; n < 2; ++n) _Pragma("unroll") for (int k = 0; k < 2; ++k) dst[n][k] = *(const LAS bf16x8*)(lds + PG8_SB(b, h) + boff + n * 2048 + k * 1024); } while (0)
#define PG8_MMA(ai, bj, At, Bt) do { __builtin_amdgcn_s_setprio(1); _Pragma("unroll") for (int m = 0; m < 4; ++m) _Pragma("unroll") for (int n = 0; n < 2; ++n) _Pragma("unroll") for (int k = 0; k < 2; ++k) \
        acc[ai][bj][m][n] = __builtin_amdgcn_mfma_f32_16x16x32_bf16(Bt[n][k], At[m][k], acc[ai][bj][m][n], 0, 0, 0); __builtin_amdgcn_s_setprio(0); } while (0)
#define PG8_WAIT_V(n) asm volatile("s_waitcnt vmcnt(" #n ")" ::: "memory")
#define PG8_WAIT_L(n) asm volatile("s_waitcnt lgkmcnt(" #n ")" ::: "memory")
#define PG8_BAR __builtin_amdgcn_s_barrier()
#define PG8_SCHED __builtin_amdgcn_sched_barrier(0)
    Unit cur, nxt; int ui = 0;
    if (!S.next(0, cur)) return;
    Acc acc;
#pragma unroll
    for (int a = 0; a < 2; ++a)
#pragma unroll
        for (int b = 0; b < 2; ++b)
#pragma unroll
            for (int m = 0; m < 4; ++m)
#pragma unroll
                for (int n = 0; n < 2; ++n) acc[a][b][m][n] = (f32x4){0.f, 0.f, 0.f, 0.f};
    bf16x8 At[4][2], B0[2][2], B1[2][2];
    const char* cA = (const char*)g.A + (size_t)cur.pm * tstepA; const char* cB = (const char*)g.Bt + (size_t)cur.pn * tstepB;
    const int ksp = g.ksp; const char* cA2 = (const char*)g.A2 + (size_t)cur.pm * tstepA - (size_t)ksp * kstep;
#define PG8_APTR(kt) (((kt) < ksp ? cA : cA2) + (size_t)(kt) * kstep)
    PG8_STAGE(PG8_SB(0, 0), cB, voffB); PG8_STAGE(PG8_SB(0, 1), cB + hstepB, voffB); PG8_STAGE(PG8_SA(0, 0), cA, voffA); PG8_STAGE(PG8_SA(0, 1), cA + hstepA, voffA);
    if (wr == 1) PG8_BAR;
    PG8_WAIT_V(2); PG8_BAR;
    PG8_STAGE(PG8_SB(1, 0), cB + kstep, voffB); PG8_STAGE(PG8_SA(1, 0), cA + kstep, voffA); PG8_STAGE(PG8_SB(1, 1), cB + hstepB + kstep, voffB);
    PG8_WAIT_V(6); PG8_BAR;
    for (;;) {
        const bool has_next = S.next(ui + 1, nxt);
        const char* nA = has_next ? (const char*)g.A + (size_t)nxt.pm * tstepA : cA; const char* nB = has_next ? (const char*)g.Bt + (size_t)nxt.pn * tstepB : cB;
        const char* nA2 = has_next ? (const char*)g.A2 + (size_t)nxt.pm * tstepA - (size_t)ksp * kstep : cA2;
#pragma unroll 1
        for (int t = 0; t < nt; t += 2) {
            const bool last = (t == nt - 2);
            const char* a1 = PG8_APTR(t + 1);
            const char* a2 = last ? nA : PG8_APTR(t + 2); const char* b2 = last ? nB : cB + (size_t)(t + 2) * kstep;
            const char* a3 = a2 + kstep; const char* b3 = b2 + kstep;
            PG8_LDB(B0, 0, 0); PG8_LDB(B1, 0, 1); PG8_SCHED; PG8_LDA(At, 0, 0); PG8_STAGE(PG8_SA(1, 1), a1 + hstepA, voffA);
            PG8_WAIT_V(8); PG8_WAIT_L(0); PG8_BAR; PG8_MMA(0, 0, At, B0); PG8_MMA(0, 1, At, B1); PG8_BAR; PG8_SCHED;
            PG8_LDA(At, 0, 1); PG8_STAGE(PG8_SB(0, 0), b2, voffB); PG8_STAGE(PG8_SB(0, 1), b2 + hstepB, voffB); PG8_STAGE(PG8_SA(0, 0), a2, voffA);
            PG8_WAIT_V(8); PG8_WAIT_L(0); PG8_BAR; PG8_MMA(1, 0, At, B0); PG8_MMA(1, 1, At, B1); PG8_BAR; PG8_SCHED;
            PG8_LDB(B0, 1, 0); PG8_LDB(B1, 1, 1); PG8_SCHED; PG8_LDA(At, 1, 0); PG8_STAGE(PG8_SA(0, 1), a2 + hstepA, voffA);
            PG8_WAIT_V(8); PG8_WAIT_L(0); PG8_BAR; PG8_MMA(0, 0, At, B0); PG8_MMA(0, 1, At, B1); PG8_BAR; PG8_SCHED;
            PG8_LDA(At, 1, 1); PG8_STAGE(PG8_SB(1, 0), b3, voffB); PG8_STAGE(PG8_SB(1, 1), b3 + hstepB, voffB); PG8_STAGE(PG8_SA(1, 0), a3, voffA);
            PG8_WAIT_V(8); PG8_WAIT_L(0); PG8_BAR; PG8_MMA(1, 0, At, B0); PG8_MMA(1, 1, At, B1); PG8_BAR; PG8_SCHED;
        }
        if (wr == 0) PG8_BAR;
        { int t2 = threadIdx.x; asm volatile("" : "+v"(t2)); const int l2 = t2 & 63; E(acc, cur, wr, wc, l2 & 15, l2 >> 4); }
        if (!has_next) break;
#pragma unroll
        for (int a = 0; a < 2; ++a)
#pragma unroll
            for (int b = 0; b < 2; ++b)
#pragma unroll
                for (int m = 0; m < 4; ++m)
#pragma unroll
                    for (int n = 0; n < 2; ++n) acc[a][b][m][n] = (f32x4){0.f, 0.f, 0.f, 0.f};
        cur = nxt; cA = nA; cB = nB; cA2 = nA2; ++ui;
        if (wr == 1) PG8_BAR;
    }
    PG8_WAIT_V(0);
    PG8_BAR;
#undef PG8_APTR
#undef PG8_SA
#undef PG8_SB
#undef PG8_STAGE
#undef PG8_LDA
#undef PG8_LDB
#undef PG8_MMA
#undef PG8_WAIT_V
#undef PG8_WAIT_L
#undef PG8_BAR
#undef PG8_SCHED
}
}

__device__ __forceinline__ void transpose_item(const Params& p, int jidx, int item, LAS float* scr, int lane) {
    const Job& jb = p.jobs[jidx];
    const float* src = jb.src; bf16_t* dst = jb.dst;
    const int ldsrc = jb.ldsrc, G = jb.G, lddst = jb.lddst, Nc = jb.Nc;
    const float scale = jb.scale;
    const int nblk = Nc / 32, kb = item / nblk, nb = item % nblk, k0 = 64 * kb, j0 = 32 * nb;
    const int grp = j0 / G, jin = j0 % G;
    const int srccol0 = jb.c0 + grp * jb.sstride + jin, dstrow0 = jb.r0 + grp * jb.dstride + jin;
    if (src) {
#pragma unroll 8
        for (int i = 0; i < 32; ++i) { const int kk = 2 * i + (lane >> 5); scr[kk * 33 + (lane & 31)] = src[(size_t)(k0 + kk) * ldsrc + srccol0 + (lane & 31)] * scale; }
    } else {
#pragma unroll 8
        for (int i = 0; i < 32; ++i) { const int kk = 2 * i + (lane >> 5); scr[kk * 33 + (lane & 31)] = 0.f; }
    }
    LDS_WAIT(); asm volatile("" ::: "memory");
    const int c = lane & 7;
    f32x4 g0 = (f32x4){1.f, 1.f, 1.f, 1.f}, g1 = g0;
    if (src && jb.kscale) { g0 = *(const f32x4*)(jb.kscale + k0 + 8 * c); g1 = *(const f32x4*)(jb.kscale + k0 + 8 * c + 4); }
#pragma unroll
    for (int j = 0; j < 4; ++j) { const int n = (lane >> 3) + 8 * j; const LAS float* s = scr + (8 * c) * 33 + n;
        u32x4 o; o.x = pk_bf16(s[0 * 33] * g0.x, s[1 * 33] * g0.y); o.y = pk_bf16(s[2 * 33] * g0.z, s[3 * 33] * g0.w); o.z = pk_bf16(s[4 * 33] * g1.x, s[5 * 33] * g1.y); o.w = pk_bf16(s[6 * 33] * g1.z, s[7 * 33] * g1.w);
        *(u32x4*)(dst + (size_t)(dstrow0 + n) * lddst + jb.dk0 + k0 + 8 * c) = o; }
    LDS_WAIT(); asm volatile("" ::: "memory");
}
__device__ __forceinline__ void weights_phase(const Params& p, LAS unsigned char* lds, int gw, int NGW, int wave, int lane) {
    LAS float* scr = (LAS float*)(lds + wave * 8704);
    for (int it = gw; it < p.nitems; it += NGW) {
        int j = 0;
        for (int q = 1; q < p.njobs; ++q) if (p.jobs[q].item0 <= it) j = q;
        j = __builtin_amdgcn_readfirstlane(j);
        transpose_item(p, j, it - p.jobs[j].item0, scr, lane);
    }
}

__device__ __forceinline__ void norm_phase(const float* x, const float* g, bf16_t* out, int gw, int NGW, int lane) {
    f32x4 gv[4];
#pragma unroll
    for (int j = 0; j < 4; ++j) gv[j] = *((const f32x4*)g + lane + 64 * j);
    for (int m = gw; m < T_ / 2; m += NGW) {
        const f32x4* xr = (const f32x4*)(x + (size_t)m * D_) + lane; const f32x4* xq = xr + (size_t)(T_ / 2) * (D_ / 4);
        f32x4 v[4], u[4]; float s = 0.f, t = 0.f;
#pragma unroll
        for (int j = 0; j < 4; ++j) { v[j] = xr[64 * j]; u[j] = xq[64 * j]; }
#pragma unroll
        for (int j = 0; j < 4; ++j) { s += (v[j].x * v[j].x + v[j].y * v[j].y) + (v[j].z * v[j].z + v[j].w * v[j].w); t += (u[j].x * u[j].x + u[j].y * u[j].y) + (u[j].z * u[j].z + u[j].w * u[j].w); }
        const float rs = 1.0f / sqrtf(wave_sum(s) * (1.f / D_) + 1e-6f), rt = 1.0f / sqrtf(wave_sum(t) * (1.f / D_) + 1e-6f);
        u32x2* o = (u32x2*)(out + (size_t)m * D_) + lane; u32x2* oq = o + (size_t)(T_ / 2) * (D_ / 4);
#pragma unroll
        for (int j = 0; j < 4; ++j) { const f32x4 y = v[j] * rs * gv[j]; u32x2 w; w.x = pk_bf16(y.x, y.y); w.y = pk_bf16(y.z, y.w); o[64 * j] = w;
                                      const f32x4 z = u[j] * rt * gv[j]; u32x2 w2; w2.x = pk_bf16(z.x, z.y); w2.y = pk_bf16(z.z, z.w); oq[64 * j] = w2; }
    }
}
__device__ __forceinline__ f32x4 ld_bf4(const bf16_t* p) { const u32x2 w = *(const u32x2*)p; return (f32x4){bf_lo(w.x), bf_hi(w.x), bf_lo(w.y), bf_hi(w.y)}; }
__device__ __forceinline__ void final_norm_phase(const bf16_t* x, int src_off, float* out, const float* g, int r0, int r1, const bf16_t* cx, bf16_t* cpy, int c0, int c1, int gw, int NGW, int lane) {
    f32x4 gv[4];
#pragma unroll
    for (int j = 0; j < 4; ++j) gv[j] = *((const f32x4*)g + lane + 64 * j);
    for (int m = r0 + gw; m < r1; m += NGW) {
        const bf16_t* xr = x + (size_t)(m - src_off) * D_ + 4 * lane;
        f32x4 v[4]; float s = 0.f;
#pragma unroll
        for (int j = 0; j < 4; ++j) { v[j] = ld_bf4(xr + 256 * j); s += (v[j].x * v[j].x + v[j].y * v[j].y) + (v[j].z * v[j].z + v[j].w * v[j].w); }
        const float rstd = 1.0f / sqrtf(wave_sum(s) * (1.f / D_) + 1e-6f);
        f32x4* o = (f32x4*)(out + (size_t)m * D_) + lane;
#pragma unroll
        for (int j = 0; j < 4; ++j) o[64 * j] = v[j] * rstd * gv[j];
    }
    for (int m = c0 + gw; m < c1; m += NGW) {
        const u32x4* sp = (const u32x4*)(cx + (size_t)m * D_) + lane; u32x4* dp = (u32x4*)(cpy + (size_t)(m - c0) * D_) + lane;
        dp[0] = sp[0]; dp[64] = sp[64];
    }
}
__device__ __forceinline__ void mix_phase(const bf16_t* x, const float* g, const float* mu, bf16_t* oA, bf16_t* oB, size_t ostride, int gw, int NGW, int lane) {
    for (int m = gw; m < T_; m += NGW) {
        const int s_idx = m & (S_ - 1);
        const bf16_t* xr = x + (size_t)m * D_ + 4 * lane;
        f32x4 v[4], pv[4]; float s = 0.f, ps = 0.f;
#pragma unroll
        for (int j = 0; j < 4; ++j) { v[j] = ld_bf4(xr + 256 * j); s += (v[j].x * v[j].x + v[j].y * v[j].y) + (v[j].z * v[j].z + v[j].w * v[j].w); }
        if (s_idx > 0) {
#pragma unroll
            for (int j = 0; j < 4; ++j) { pv[j] = ld_bf4(xr + 256 * j - D_); ps += (pv[j].x * pv[j].x + pv[j].y * pv[j].y) + (pv[j].z * pv[j].z + pv[j].w * pv[j].w); }
        } else {
#pragma unroll
            for (int j = 0; j < 4; ++j) pv[j] = (f32x4){0.f, 0.f, 0.f, 0.f};
        }
        const float rstd = 1.0f / sqrtf(wave_sum(s) * (1.f / D_) + 1e-6f);
        const float prstd = 1.0f / sqrtf(wave_sum(ps) * (1.f / D_) + 1e-6f);
#pragma unroll
        for (int j = 0; j < 4; ++j) {
            const f32x4 gv = *((const f32x4*)g + lane + 64 * j);
            const f32x4 h = v[j] * rstd * gv, hh = pv[j] * prstd * gv - h;
            const size_t eo = (size_t)m * D_ + 4 * (lane + 64 * j);
#pragma unroll
            for (int q = 0; q < 6; ++q) {
                const f32x4 mq = *((const f32x4*)(mu + q * D_) + lane + 64 * j);
                const f32x4 y = h + hh * mq;
                u32x2 w; w.x = pk_bf16(y.x, y.y); w.y = pk_bf16(y.z, y.w);
                bf16_t* dst = (q == 0) ? oA : (q == 2) ? oA + ostride : (q == 3) ? oA + 2 * ostride : (q == 1) ? oB : (q == 4) ? oB + ostride : oB + 2 * ostride;
                *(u32x2*)(dst + eo) = w;
            }
        }
    }
}
__device__ __forceinline__ void latents_phase(bf16_t* ZL, const float* qn, const float* kvn, const int* pos, bf16_t* KPE, f32x2* ROPE, int gw, int NGW, int lane) {
    for (int m = gw; m < T_; m += NGW) {
        bf16_t* zr = ZL + (size_t)m * 1024;
        { u32x4 w = *((const u32x4*)zr + lane); float f[8] = {bf_lo(w.x), bf_hi(w.x), bf_lo(w.y), bf_hi(w.y), bf_lo(w.z), bf_hi(w.z), bf_lo(w.w), bf_hi(w.w)};
          float s = 0.f;
#pragma unroll
          for (int e = 0; e < 8; ++e) s += f[e] * f[e];
          const float rstd = 1.0f / sqrtf(wave_sum(s) * (1.f / 512.f) + 1e-6f);
          const f32x4 g0 = *((const f32x4*)qn + 2 * lane), g1 = *((const f32x4*)qn + 2 * lane + 1);
          u32x4 o; o.x = pk_bf16(f[0] * rstd * g0.x, f[1] * rstd * g0.y); o.y = pk_bf16(f[2] * rstd * g0.z, f[3] * rstd * g0.w);
          o.z = pk_bf16(f[4] * rstd * g1.x, f[5] * rstd * g1.y); o.w = pk_bf16(f[6] * rstd * g1.z, f[7] * rstd * g1.w);
          *((u32x4*)zr + lane) = o; }
        { u32x2 w = *((const u32x2*)(zr + 512) + lane); float f[4] = {bf_lo(w.x), bf_hi(w.x), bf_lo(w.y), bf_hi(w.y)};
          const float s = (f[0] * f[0] + f[1] * f[1]) + (f[2] * f[2] + f[3] * f[3]);
          const float rstd = 1.0f / sqrtf(wave_sum(s) * (1.f / 256.f) + 1e-6f);
          const f32x4 g0 = *((const f32x4*)kvn + lane);
          u32x2 o; o.x = pk_bf16(f[0] * rstd * g0.x, f[1] * rstd * g0.y); o.y = pk_bf16(f[2] * rstd * g0.z, f[3] * rstd * g0.w);
          *((u32x2*)(zr + 512) + lane) = o; }
        if (lane < 32) {
            const float invf = fexp2(-(float)lane * (13.287712379549449f / 32.0f));
            const float ang = (float)pos[m] * invf;
            const double rev = (double)ang * 0.15915494309189535;
            const float fr = (float)(rev - __builtin_rint(rev));
            const float cs = __builtin_amdgcn_cosf(fr), sn = __builtin_amdgcn_sinf(fr);
            ROPE[(size_t)m * 32 + lane] = (f32x2){cs, sn};
            const float x1 = __uint_as_float((unsigned)zr[768 + lane] << 16), x2 = __uint_as_float((unsigned)zr[800 + lane] << 16);
            const unsigned o1 = pk_bf16(x1 * cs - x2 * sn, 0.f), o2 = pk_bf16(x1 * sn + x2 * cs, 0.f);
            KPE[(size_t)m * 64 + lane] = (bf16_t)(o1 & 0xffffu); KPE[(size_t)m * 64 + 32 + lane] = (bf16_t)(o2 & 0xffffu);
        }
    }
}

__device__ __forceinline__ void conv_phase(LAS unsigned char* lds, const bf16_t* U, const float* cw, const float* cb, const float* lg, const float* lb, bf16_t* CONV, int vcu, int G) {
    const int tid = threadIdx.x, lane = tid & 63, wid = tid >> 6;
    LAS unsigned* ub = (LAS unsigned*)lds;
    LAS float* part = (LAS float*)(lds + 62 * 2048);
    LAS float* stat = part + 512;
    f32x2 W[31];
#pragma unroll
    for (int w = 0; w < 31; ++w) W[w] = *(const f32x2*)(cw + w * D_ + 2 * tid);
    const f32x2 bias = *(const f32x2*)(cb + 2 * tid), lgv = *(const f32x2*)(lg + 2 * tid), lbv = *(const f32x2*)(lb + 2 * tid);
    for (int item = vcu; item < NB_ * 64; item += G) {
        const int b = item >> 6, s0 = (item & 63) * 32;
        const size_t rowb = (size_t)b * S_;
        __syncthreads();
        for (int idx = tid; idx < 62 * 128; idx += 512) {
            const int r = idx >> 7, ch = idx & 127, s = s0 - 30 + r;
            u32x4 v = (u32x4){0u, 0u, 0u, 0u};
            if (s >= 0) v = *((const u32x4*)(U + (rowb + s) * D_) + ch);
            *((LAS u32x4*)(ub + r * 512) + ch) = v;
        }
        __syncthreads();
        f32x2 acc[32];
#pragma unroll
        for (int t = 0; t < 32; ++t) {
            float a0 = bias.x, a1 = bias.y;
#pragma unroll
            for (int w = 0; w < 31; ++w) { const unsigned uu = ub[(t + w) * 512 + tid];
                asm("v_fma_f32 %0, %1, %2, %0" : "+v"(a0) : "v"(bf_lo(uu)), "v"(W[w].x)); asm("v_fma_f32 %0, %1, %2, %0" : "+v"(a1) : "v"(bf_hi(uu)), "v"(W[w].y)); }
            acc[t] = (f32x2){a0, a1};
        }
#pragma unroll
        for (int t = 0; t < 32; ++t) {
            const float s1 = wave_sum(acc[t].x + acc[t].y), s2 = wave_sum(acc[t].x * acc[t].x + acc[t].y * acc[t].y);
            if (lane == 0) { part[(wid * 32 + t) * 2] = s1; part[(wid * 32 + t) * 2 + 1] = s2; }
        }
        __syncthreads();
        if (tid < 32) {
            float s1 = 0.f, s2 = 0.f;
#pragma unroll
            for (int w = 0; w < 8; ++w) { s1 += part[(w * 32 + tid) * 2]; s2 += part[(w * 32 + tid) * 2 + 1]; }
            const float mean = s1 * (1.f / D_), var = fmaxf(s2 * (1.f / D_) - mean * mean, 0.f);
            stat[tid * 2] = mean; stat[tid * 2 + 1] = 1.0f / sqrtf(var + 1e-5f);
        }
        __syncthreads();
#pragma unroll
        for (int t = 0; t < 32; ++t) {
            const float mean = stat[t * 2], rstd = stat[t * 2 + 1];
            const f32x2 hn = (acc[t] - mean) * rstd * lgv + lbv;
            const float o0 = hn.x * sigmoidf_(hn.x), o1 = hn.y * sigmoidf_(hn.y);
            *((unsigned*)(CONV + (rowb + s0 + t) * D_) + tid) = pk_bf16(o0, o1);
        }
    }
    __syncthreads();
}

namespace att {
constexpr int KP = 400, VP = 144, KT = 64 * KP, VT = 128 * VP, STG = KT + VT;
__device__ __forceinline__ void attn_unit(LAS unsigned char* lds, int b, int h, int qb, const bf16_t* Q, const bf16_t* KN, const bf16_t* KPE, const bf16_t* VTg, const f32x2* ROPE, bf16_t* ATT, const unsigned char* wsb) {
    int tid = threadIdx.x; asm volatile("" : "+v"(tid));
    const int lane = tid & 63, r32 = lane & 31, hi = lane >> 5; const int wid = __builtin_amdgcn_readfirstlane(tid >> 6);
    const size_t rowb = (size_t)b * S_; const int q0 = qb * 256;
    const int NT = (q0 + 256) / 64;
    const char* gbase = (const char*)wsb;
    const unsigned kn_off = (unsigned)((const char*)(KN + ((size_t)(b * 8 + h) * S_ + (tid >> 4)) * 128 + 8 * (tid & 15)) - gbase);
    const unsigned kp_off = (unsigned)((const char*)(KPE + (rowb + (tid >> 3)) * 64 + 8 * (tid & 7)) - gbase);
    const unsigned v_off = (unsigned)((const char*)(VTg + ((size_t)(b * 8 + h) * 32 * 128 + (tid >> 3)) * 64 + 8 * (tid & 7)) - gbase);
    const int kn_dst = (tid >> 4) * KP + (tid & 15) * 16, kp_dst = (tid >> 3) * KP + 256 + (tid & 7) * 16, v_dst = KT + (tid >> 3) * VP + (tid & 7) * 16;
    u32x4 kr[3], vr[2];
#define ATT_LOAD(t) do { kr[0] = *(const u32x4*)(gbase + (kn_off + (unsigned)(t) * 16384u)); kr[1] = *(const u32x4*)(gbase + (kn_off + (unsigned)(t) * 16384u + 8192u)); \
                         kr[2] = *(const u32x4*)(gbase + (kp_off + (unsigned)(t) * (64u * 64u * 2u))); \
                         vr[0] = *(const u32x4*)(gbase + (v_off + (unsigned)(t) * 16384u)); vr[1] = *(const u32x4*)(gbase + (v_off + (unsigned)(t) * 16384u + 8192u)); } while (0)
#define ATT_STORE(st) do { *(LAS u32x4*)(lds + (st) * STG + kn_dst) = kr[0]; *(LAS u32x4*)(lds + (st) * STG + kn_dst + 32 * KP) = kr[1]; *(LAS u32x4*)(lds + (st) * STG + kp_dst) = kr[2]; \
                          *(LAS u32x4*)(lds + (st) * STG + v_dst) = vr[0]; *(LAS u32x4*)(lds + (st) * STG + v_dst + 64 * VP) = vr[1]; } while (0)
    ATT_LOAD(0);
    const size_t qrow = rowb + q0 + wid * 32 + r32;
    bf16x8 qf[12];
#pragma unroll
    for (int d0 = 0; d0 < 12; ++d0) qf[d0] = *(const bf16x8*)(Q + qrow * 1536 + h * 192 + d0 * 16 + hi * 8);
#pragma unroll
    for (int dd = 0; dd < 2; ++dd) {
        const f32x2* rp = ROPE + qrow * 32 + 16 * dd + 8 * hi;
        u32x4 a = __builtin_bit_cast(u32x4, qf[8 + dd]), c = __builtin_bit_cast(u32x4, qf[10 + dd]);
        unsigned ao[4], co[4];
#pragma unroll
        for (int w = 0; w < 4; ++w) {
            const f32x2 cs0 = rp[2 * w], cs1 = rp[2 * w + 1];
            const float x1a = bf_lo(a[w]), x1b = bf_hi(a[w]), x2a = bf_lo(c[w]), x2b = bf_hi(c[w]);
            ao[w] = pk_bf16(x1a * cs0.x - x2a * cs0.y, x1b * cs1.x - x2b * cs1.y);
            co[w] = pk_bf16(x1a * cs0.y + x2a * cs0.x, x1b * cs1.y + x2b * cs1.x);
        }
        qf[8 + dd] = __builtin_bit_cast(bf16x8, (u32x4){ao[0], ao[1], ao[2], ao[3]});
        qf[10 + dd] = __builtin_bit_cast(bf16x8, (u32x4){co[0], co[1], co[2], co[3]});
    }
    f32x16 o[4];
#pragma unroll
    for (int db = 0; db < 4; ++db)
#pragma unroll
        for (int r = 0; r < 16; ++r) o[db][r] = 0.f;
    float mrun = -1e30f, lrun = 0.f;
#pragma unroll
    for (int d0 = 0; d0 < 12; ++d0) asm volatile("" : "+v"(qf[d0]));
    const int kperm = 16 * ((r32 >> 2) & 1) + 4 * (r32 >> 3) + (r32 & 3);
    const int koff = kperm * KP + hi * 16;
    const int voff = KT + r32 * VP + hi * 32;
    const int qrel = wid * 32 + r32;
    ATT_STORE(0);
    __syncthreads();
    for (int t = 0; t < NT; ++t) {
        const int st = t & 1;
        if (t + 1 < NT) ATT_LOAD(t + 1);
        const int jb = t - (NT - 4);
        if (jb <= (wid >> 1)) {
            const LAS unsigned char* kb = lds + st * STG + koff;
            f32x16 p0, p1;
#pragma unroll
            for (int r = 0; r < 16; ++r) { p0[r] = 0.f; p1[r] = 0.f; }
#pragma unroll
            for (int d0 = 0; d0 < 12; ++d0) {
                const bf16x8 k0 = *(const LAS bf16x8*)(kb + d0 * 32), k1 = *(const LAS bf16x8*)(kb + 32 * KP + d0 * 32);
                p0 = __builtin_amdgcn_mfma_f32_32x32x16_bf16(k0, qf[d0], p0, 0, 0, 0);
                p1 = __builtin_amdgcn_mfma_f32_32x32x16_bf16(k1, qf[d0], p1, 0, 0, 0);
            }
            if (jb >= 0) {
                const int kv0 = 64 * jb + 16 * hi;
#pragma unroll
                for (int r = 0; r < 16; ++r) { if (kv0 + r > qrel) p0[r] = -INFINITY; if (kv0 + 32 + r > qrel) p1[r] = -INFINITY; }
            }
            float rm = fmaxf(p0[0], p1[0]);
#pragma unroll
            for (int r = 1; r < 16; ++r) rm = fmaxf(rm, fmaxf(p0[r], p1[r]));
            rm = fmaxf(rm, __shfl_xor(rm, 32));
            const float mnew = fmaxf(mrun, rm), alpha = fexp2(mrun - mnew);
            mrun = mnew;
            float ls = 0.f;
#pragma unroll
            for (int r = 0; r < 16; ++r) { p0[r] = fexp2(p0[r] - mnew); p1[r] = fexp2(p1[r] - mnew); ls += p0[r] + p1[r]; }
            lrun = lrun * alpha + ls;
#pragma unroll
            for (int db = 0; db < 4; ++db)
#pragma unroll
                for (int r = 0; r < 16; ++r) o[db][r] *= alpha;
            const LAS unsigned char* vb = lds + st * STG + voff;
#pragma unroll
            for (int gg = 0; gg < 2; ++gg)
#pragma unroll
                for (int j = 0; j < 2; ++j) {
                    u32x4 pw;
                    if (gg == 0) { pw.x = pk_bf16(p0[8 * j], p0[8 * j + 1]); pw.y = pk_bf16(p0[8 * j + 2], p0[8 * j + 3]); pw.z = pk_bf16(p0[8 * j + 4], p0[8 * j + 5]); pw.w = pk_bf16(p0[8 * j + 6], p0[8 * j + 7]); }
                    else         { pw.x = pk_bf16(p1[8 * j], p1[8 * j + 1]); pw.y = pk_bf16(p1[8 * j + 2], p1[8 * j + 3]); pw.z = pk_bf16(p1[8 * j + 4], p1[8 * j + 5]); pw.w = pk_bf16(p1[8 * j + 6], p1[8 * j + 7]); }
                    const bf16x8 pf = __builtin_bit_cast(bf16x8, pw);
#pragma unroll
                    for (int db = 0; db < 4; ++db) {
                        const bf16x8 vf = *(const LAS bf16x8*)(vb + db * 32 * VP + gg * 64 + j * 16);
                        o[db] = __builtin_amdgcn_mfma_f32_32x32x16_bf16(vf, pf, o[db], 0, 0, 0);
                    }
                }
        }
        if (t + 1 < NT) ATT_STORE(st ^ 1);
        __syncthreads();
    }
    const float ltot = lrun + __shfl_xor(lrun, 32);
    const float inv = 1.0f / ltot;
    bf16_t* orow = ATT + qrow * D_ + h * 128;
#pragma unroll
    for (int db = 0; db < 4; ++db)
#pragma unroll
        for (int rg = 0; rg < 4; ++rg) {
            u32x2 w; w.x = pk_bf16(o[db][4 * rg] * inv, o[db][4 * rg + 1] * inv); w.y = pk_bf16(o[db][4 * rg + 2] * inv, o[db][4 * rg + 3] * inv);
            *(u32x2*)(orow + 32 * db + 8 * rg + 4 * hi) = w;
        }
#undef ATT_LOAD
#undef ATT_STORE
}
}

namespace scan {
constexpr int CH = 32;
constexpr int O_NKK = 0, O_W = CH * 64, O_BV = 2 * CH * 64, O_KP = 3 * CH * 64, O_RR = 4 * CH * 64, O_VV = 5 * CH * 64, O_GG = 6 * CH * 64, O_BON = 7 * CH * 64, O_YB = 7 * CH * 64 + 64, O_GAM = O_YB + CH * 64, O_VT = O_GAM + 64;
__device__ __forceinline__ float red8(float x) {
    x += __int_as_float(__builtin_amdgcn_update_dpp(0, __float_as_int(x), 0xB1, 0xF, 0xF, true));
    x += __int_as_float(__builtin_amdgcn_update_dpp(0, __float_as_int(x), 0x4E, 0xF, 0xF, true));
    x += __int_as_float(__builtin_amdgcn_update_dpp(0, __float_as_int(x), 0x141, 0xF, 0xF, true));
    return x;
}
__device__ __forceinline__ void scan_unit(LAS unsigned char* lds, int b, int h, const bf16_t* R, const bf16_t* K, const bf16_t* V, const bf16_t* WAG,
                                          const float* k_k, const float* k_a, const float* r_k, const float* ln_g, const float* ln_b, bf16_t* YG) {
    const int tid = threadIdx.x;
    LAS float* L = (LAS float*)lds;
    const int i = tid >> 3, c = tid & 7;
    const int ps = tid >> 4, pj = (tid & 15) * 4;
    const size_t rowb = (size_t)b * S_;
    const int hc = h * 64 + pj;
    const f32x4 kk4 = *(const f32x4*)(k_k + hc), ka4 = *(const f32x4*)(k_a + hc), rk4 = *(const f32x4*)(r_k + hc), lg4 = *(const f32x4*)(ln_g + hc), lb4 = *(const f32x4*)(ln_b + hc);
    f32x2 S2[4];
#pragma unroll
    for (int j = 0; j < 4; ++j) S2[j] = (f32x2){0.f, 0.f};
    u32x2 pr, pk, pvv, pe, pa, pg;
#define SCAN_LOAD(chk) do { const size_t tt = rowb + (size_t)(chk) * CH + ps; \
        pr = *(const u32x2*)(R + tt * D_ + hc); pk = *(const u32x2*)(K + tt * D_ + hc); pvv = *(const u32x2*)(V + tt * D_ + hc); \
        pe = *(const u32x2*)(WAG + tt * 3072 + hc); pa = *(const u32x2*)(WAG + tt * 3072 + 1024 + hc); pg = *(const u32x2*)(WAG + tt * 3072 + 2048 + hc); } while (0)
    SCAN_LOAD(0);
    for (int chk = 0; chk < S_ / CH; ++chk) {
        __syncthreads();
        {
            const f32x4 r4 = {bf_lo(pr.x), bf_hi(pr.x), bf_lo(pr.y), bf_hi(pr.y)}, k4 = {bf_lo(pk.x), bf_hi(pk.x), bf_lo(pk.y), bf_hi(pk.y)}, v4 = {bf_lo(pvv.x), bf_hi(pvv.x), bf_lo(pvv.y), bf_hi(pvv.y)};
            const f32x4 e4 = {h_lo(pe.x), h_hi(pe.x), h_lo(pe.y), h_hi(pe.y)}, a4 = {h_lo(pa.x), h_hi(pa.x), h_lo(pa.y), h_hi(pa.y)}, g4 = {h_lo(pg.x), h_hi(pg.x), h_lo(pg.y), h_hi(pg.y)};
            const int o = ps * 64 + pj;
            const f32x4 kkr = k4 * kk4;
            const float ss = sum16((kkr.x * kkr.x + kkr.y * kkr.y) + (kkr.z * kkr.z + kkr.w * kkr.w));
            const float inv = 1.0f / fmaxf(sqrtf(ss), 1e-12f);
            const f32x4 kk = kkr * inv;
            const f32x4 kp = k4 * (1.0f + (a4 - 1.0f) * ka4);
            const f32x4 bv = kk * a4;
            const f32x4 bt = r4 * kp * rk4;
            const float bon = sum16((bt.x + bt.y) + (bt.z + bt.w));
            f32x4 cum = e4;
            { const int lg = (tid >> 4) & 3;
              f32x4 u; u.x = __shfl_up(cum.x, 16); u.y = __shfl_up(cum.y, 16); u.z = __shfl_up(cum.z, 16); u.w = __shfl_up(cum.w, 16);
              if (lg >= 1) cum += u;
              u.x = __shfl_up(cum.x, 32); u.y = __shfl_up(cum.y, 32); u.z = __shfl_up(cum.z, 32); u.w = __shfl_up(cum.w, 32);
              if (lg >= 2) cum += u;
              if (lg == 3) *(LAS f32x4*)(L + O_W + (tid >> 6) * 64 + pj) = cum; }
            __syncthreads();
            { const int wv = tid >> 6;
              for (int w2 = 0; w2 < wv; ++w2) cum += *(const LAS f32x4*)(L + O_W + w2 * 64 + pj); }
            f32x4 gs, gp, gi;
            gs.x = fexp2(-cum.x * LOG2E); gs.y = fexp2(-cum.y * LOG2E); gs.z = fexp2(-cum.z * LOG2E); gs.w = fexp2(-cum.w * LOG2E);
            gi.x = fexp2(cum.x * LOG2E); gi.y = fexp2(cum.y * LOG2E); gi.z = fexp2(cum.z * LOG2E); gi.w = fexp2(cum.w * LOG2E);
            const f32x4 cp = cum - e4;
            gp.x = fexp2(-cp.x * LOG2E); gp.y = fexp2(-cp.y * LOG2E); gp.z = fexp2(-cp.z * LOG2E); gp.w = fexp2(-cp.w * LOG2E);
            *(LAS f32x4*)(L + O_NKK + o) = -(kk * gp); *(LAS f32x4*)(L + O_BV + o) = bv * gi; *(LAS f32x4*)(L + O_KP + o) = kp * gi;
            *(LAS f32x4*)(L + O_RR + o) = r4 * gs; *(LAS f32x4*)(L + O_VV + o) = v4; *(LAS f32x4*)(L + O_GG + o) = g4;
            if (ps == CH - 1) *(LAS f32x4*)(L + O_GAM + pj) = gs;
            { LAS float* vt = L + O_VT + (ps >> 2) * 256 + pj * 4 + (ps & 3); vt[0] = v4.x; vt[4] = v4.y; vt[8] = v4.z; vt[12] = v4.w; }
            if ((tid & 15) == 0) L[O_BON + ps] = bon;
        }
        __syncthreads();
        if (chk + 1 < S_ / CH) SCAN_LOAD(chk + 1);
        f32x4 vq = (f32x4){0.f, 0.f, 0.f, 0.f};
#pragma unroll 4
        for (int s = 0; s < CH; ++s) {
            const int o = s * 64 + 8 * c;
            if ((s & 3) == 0) vq = *(const LAS f32x4*)(L + O_VT + (s >> 2) * 256 + i * 4);
            const f32x4 n0 = *(const LAS f32x4*)(L + O_NKK + o), n1 = *(const LAS f32x4*)(L + O_NKK + o + 4);
            const f32x4 b0 = *(const LAS f32x4*)(L + O_BV + o), b1 = *(const LAS f32x4*)(L + O_BV + o + 4);
            const f32x4 q0 = *(const LAS f32x4*)(L + O_KP + o), q1 = *(const LAS f32x4*)(L + O_KP + o + 4);
            const f32x4 r0 = *(const LAS f32x4*)(L + O_RR + o), r1 = *(const LAS f32x4*)(L + O_RR + o + 4);
            const float vi = (s & 3) == 0 ? vq.x : (s & 3) == 1 ? vq.y : (s & 3) == 2 ? vq.z : vq.w;
            f32x2 a2 = S2[0] * (f32x2){n0.x, n0.y};
            a2 += S2[1] * (f32x2){n0.z, n0.w}; a2 += S2[2] * (f32x2){n1.x, n1.y}; a2 += S2[3] * (f32x2){n1.z, n1.w};
            const float sa = red8(a2.x + a2.y);
            const f32x2 sa2 = {sa, sa}, vi2 = {vi, vi};
            S2[0] += (f32x2){b0.x, b0.y} * sa2; S2[0] += (f32x2){q0.x, q0.y} * vi2;
            S2[1] += (f32x2){b0.z, b0.w} * sa2; S2[1] += (f32x2){q0.z, q0.w} * vi2;
            S2[2] += (f32x2){b1.x, b1.y} * sa2; S2[2] += (f32x2){q1.x, q1.y} * vi2;
            S2[3] += (f32x2){b1.z, b1.w} * sa2; S2[3] += (f32x2){q1.z, q1.w} * vi2;
            f32x2 y2 = S2[0] * (f32x2){r0.x, r0.y};
            y2 += S2[1] * (f32x2){r0.z, r0.w}; y2 += S2[2] * (f32x2){r1.x, r1.y}; y2 += S2[3] * (f32x2){r1.z, r1.w};
            const float y = red8(y2.x + y2.y);
            if (c == 0) L[O_YB + s * 64 + i] = y;
        }
        { const f32x4 g0 = *(const LAS f32x4*)(L + O_GAM + 8 * c), g1 = *(const LAS f32x4*)(L + O_GAM + 8 * c + 4);
          S2[0] *= (f32x2){g0.x, g0.y}; S2[1] *= (f32x2){g0.z, g0.w}; S2[2] *= (f32x2){g1.x, g1.y}; S2[3] *= (f32x2){g1.z, g1.w}; }
        __syncthreads();
        {
            const int o = ps * 64 + pj;
            const f32x4 y4 = *(const LAS f32x4*)(L + O_YB + o), v4 = *(const LAS f32x4*)(L + O_VV + o), g4 = *(const LAS f32x4*)(L + O_GG + o);
            const float bon = L[O_BON + ps];
            const float mu = sum16((y4.x + y4.y) + (y4.z + y4.w)) * (1.f / 64.f);
            const f32x4 d = y4 - mu;
            const float var = sum16((d.x * d.x + d.y * d.y) + (d.z * d.z + d.w * d.w)) * (1.f / 64.f);
            const float rstd = 1.0f / sqrtf(var + 64e-5f);
            const f32x4 out = (d * rstd * lg4 + lb4 + v4 * bon) * g4;
            u32x2 w; w.x = pk_bf16(out.x, out.y); w.y = pk_bf16(out.z, out.w);
            *(u32x2*)(YG + (rowb + (size_t)chk * CH + ps) * D_ + hc) = w;
        }
    }
    __syncthreads();
#undef SCAN_LOAD
}
}


#define XB_TMO      128
#define XB_XCNT(j)  (256  + 64 * (j))
#define XB_XSUB(j)  (1280 + 64 * (j))
#define XB_XGEN(j)  (2304 + 64 * (j))
#define XB_TOP      3328
#define XB_TOPGEN   3392
#define XCD_BAR_WORDS 3456
#define XB_SPIN_CAP (1u << 18)
constexpr size_t WS_CTL = 500 * MiB, CTL_BYTES = 16384;
constexpr int LDS_MISC_OFF = LDS_BYTES - 64;
__device__ __forceinline__ unsigned xb_ld(unsigned* p)              { return __hip_atomic_load(p, __ATOMIC_RELAXED, __HIP_MEMORY_SCOPE_AGENT); }
__device__ __forceinline__ unsigned xb_add(unsigned* p, unsigned v) { return __hip_atomic_fetch_add(p, v, __ATOMIC_RELAXED, __HIP_MEMORY_SCOPE_AGENT); }
__device__ __forceinline__ unsigned xb_xcc_id() { return (unsigned)__builtin_amdgcn_s_getreg((3 << 11) | 20) & 0xFu; }
#define XB_SPIN(cond, bar) do { unsigned _sp = 0; while (cond) { __builtin_amdgcn_s_sleep(1); \
    if ((++_sp & 255u) == 0u) { if (xb_ld(&(bar)[XB_TMO])) break; if (_sp > XB_SPIN_CAP) { atomicAdd(&(bar)[XB_TMO], 1u); break; } } } } while (0)
struct XcdBarrier { unsigned* bar; unsigned x; volatile LAS unsigned* st; };
__device__ __forceinline__ XcdBarrier xcd_barrier_post(unsigned* bar, volatile LAS unsigned* st) {
    XcdBarrier b; b.bar = bar; b.x = xb_xcc_id(); b.st = st;
    if (threadIdx.x == 0) (void)xb_add(&bar[XB_XCNT(b.x)], 1u);
    return b;
}
__device__ __forceinline__ void xcd_barrier_complete(unsigned* bar, unsigned x, unsigned& nloc, unsigned& nx) {
    const unsigned G = gridDim.x * gridDim.y * gridDim.z;
    unsigned sum, cnt, mine, sp = 0u;
    for (;;) {
        sum = 0u; cnt = 0u; mine = 0u;
#pragma unroll
        for (unsigned j = 0; j < 16; ++j) { const unsigned c = xb_ld(&bar[XB_XCNT(j)]); sum += c; cnt += (c > 0u) ? 1u : 0u; mine = (j == x) ? c : mine; }
        if (sum == G) break;
        __builtin_amdgcn_s_sleep(1);
        if ((++sp & 255u) == 0u) { if (xb_ld(&bar[XB_TMO])) break; if (sp > XB_SPIN_CAP) { atomicAdd(&bar[XB_TMO], 1u); break; } }
    }
    nloc = mine > 0u ? mine : 1u; nx = cnt > 0u ? cnt : 1u;
}
__device__ __forceinline__ void xcd_barrier(const XcdBarrier& b) {
    asm volatile("s_waitcnt vmcnt(0)" ::: "memory");
    __syncthreads();
    if (threadIdx.x == 0) {
        unsigned* bar = b.bar;
        __builtin_amdgcn_s_waitcnt(0);
        unsigned nloc = b.st[0], nx = b.st[1];
        if (nloc == 0u) { xcd_barrier_complete(bar, b.x, nloc, nx); b.st[0] = nloc; b.st[1] = nx; }
        const unsigned old = xb_add(&bar[XB_XSUB(b.x)], 1u);
        const unsigned gen = old / nloc;
        if (old + 1u == (gen + 1u) * nloc) {
            __builtin_amdgcn_fence(__ATOMIC_RELEASE, "agent");
            asm volatile("s_waitcnt vmcnt(0)" ::: "memory");
            const unsigned og = xb_add(&bar[XB_TOP], 1u);
            const unsigned tg = og / nx;
            if (og + 1u == (tg + 1u) * nx) xb_add(&bar[XB_TOPGEN], 1u);
            else XB_SPIN(xb_ld(&bar[XB_TOPGEN]) == tg, bar);
            __builtin_amdgcn_fence(__ATOMIC_ACQUIRE, "agent");
            xb_add(&bar[XB_XGEN(b.x)], 1u);
            asm volatile("s_waitcnt vmcnt(0)" ::: "memory");
        } else {
            XB_SPIN(xb_ld(&bar[XB_XGEN(b.x)]) == gen, bar);
            __builtin_amdgcn_fence(__ATOMIC_ACQUIRE, "agent");
            asm volatile("s_waitcnt vmcnt(0)" ::: "memory");
        }
    }
    __syncthreads();
}

__device__ __forceinline__ int fresh_lane() { int t = threadIdx.x; asm volatile("" : "+v"(t)); return t & 63; }
#ifndef PHMASK
#define PHMASK 0xFFFF
#endif
#define EN(n) (((PHMASK) >> (n)) & 1)
constexpr int N_PHASES = 21;
__global__ void __launch_bounds__(512, 2) mega_fwd(Params p) {
    extern __shared__ __attribute__((aligned(16))) unsigned char smem[];
    LAS unsigned char* lds = (LAS unsigned char*)smem;
    __builtin_assume(__builtin_amdgcn_workitem_id_y() == 0); __builtin_assume(__builtin_amdgcn_workitem_id_z() == 0);
    cg::grid_group grid = cg::this_grid();
    const int tid = threadIdx.x, wave = __builtin_amdgcn_readfirstlane(tid >> 6);
    const int G = gridDim.x, bx = blockIdx.x;
    const int vcu = (G % 8 == 0) ? (bx % 8) * (G / 8) + bx / 8 : bx;
    const int gw = vcu * 8 + wave, NGW = G * 8;
    unsigned char* ws = p.ws;
    bf16_t* X = (bf16_t*)((unsigned char*)p.out + 64 * MiB);
    if (tid < 16) ((volatile LAS unsigned*)(lds + LDS_MISC_OFF))[tid] = 0u;
    __syncthreads();
    if (bx == 0) for (int i = tid; i < (int)(CTL_BYTES / 4); i += 512) __hip_atomic_store((unsigned*)(ws + WS_CTL) + i, 0u, __ATOMIC_RELAXED, __HIP_MEMORY_SCOPE_AGENT);
    XcdBarrier xbar; xbar.bar = (unsigned*)(ws + WS_CTL); xbar.x = xb_xcc_id(); xbar.st = (volatile LAS unsigned*)(lds + LDS_MISC_OFF);
    bf16_t* XN = (bf16_t*)(ws + WS_XN);
    const int lo = p.ph_lo, hi = p.ph_hi;
    int ph = 0;
#ifndef PROBE_MASK
#define PROBE_MASK 0ull
#endif
    unsigned long long t_acc = 0ull, t_ph = 0ull;
    if (PROBE_MASK) t_ph = __builtin_amdgcn_s_memrealtime();
#define IN_PH() (lo <= ph && ph < hi)
#define END_PH() do { if (lo <= ph && ph + 1 < hi) { if (ph == 0) { grid.sync(); if (tid == 0) (void)xb_add(&xbar.bar[XB_XCNT(xbar.x)], 1u); } else xcd_barrier(xbar); } \
        if (PROBE_MASK) { const unsigned long long tn_ = __builtin_amdgcn_s_memrealtime(); if ((PROBE_MASK >> ph) & 1ull) t_acc += tn_ - t_ph; t_ph = tn_; } ++ph; } while (0)
#define GEMM_RUN(EpiT, Ev, Aop, Bop, M_, N_, K_, lda_, ldb_) do { pg8::Gemm g_{(const bf16_t*)(Aop), (const bf16_t*)(Bop), (M_), (N_), (K_), (lda_), (ldb_), (const bf16_t*)(Aop), 1 << 28}; pg8::StaticOrder S_o; S_o.init((M_), (N_), G, bx); \
        pg8::gemm_phase<EpiT>(lds, g_, S_o, Ev); } while (0)

    float* SS = (float*)(ws + WS_SS);
#define FFN_GU(f_, A_, ss_) do { if (IN_PH() && EN(2)) { pg8::EpiPair<0> E{(bf16_t*)(ws + WS_HID), FF_, 1 << 30, nullptr, 0, (ss_), (LAS float*)(lds + 131072)}; \
        GEMM_RUN(pg8::EpiPair<0>, E, (A_), ws + WS_FFN + (f_) * FFN_STRIDE, T_, 2 * FF_, D_, D_, D_); } END_PH(); } while (0)
#define FFN_DN(f_, BF32_, ST_, base_) do { if (IN_PH() && EN(3)) { pg8::EpiRes<BF32_, ST_> E{(const void*)(base_), X, 0.5f, SS}; \
        GEMM_RUN(pg8::EpiRes<BF32_ _C_ ST_>, E, ws + WS_HID, ws + WS_FFN + (f_) * FFN_STRIDE + FFN_DN_OFF, T_, D_, FF_, FF_, FF_); } END_PH(); } while (0)
#define _C_ ,

    if (IN_PH()) {
        if (EN(0)) weights_phase(p, lds, gw, NGW, wave, fresh_lane());
        if (EN(1)) norm_phase(p.in[0], p.in[2], XN, gw, NGW, fresh_lane());
    }
    END_PH();
    FFN_GU(0, XN, (const float*)nullptr);
    FFN_DN(0, true, true, p.in[0]);
    if (IN_PH() && EN(4)) { pg8::EpiPair<1> E{(bf16_t*)(ws + WS_U), D_, 8, (bf16_t*)(ws + WS_ZL), 1024, SS, (LAS float*)(lds + 131072)}; GEMM_RUN(pg8::EpiPair<1>, E, X, ws + WS_WIN, T_, 3072, D_, D_, D_); }
    END_PH();
    if (IN_PH()) {
        if (EN(5)) conv_phase(lds, (const bf16_t*)(ws + WS_U), p.in[8], p.in[9], p.in[10], p.in[11], (bf16_t*)(ws + WS_CONV), vcu, G);
        if (EN(6)) latents_phase((bf16_t*)(ws + WS_ZL), p.in[12], p.in[14], (const int*)p.in[1], (bf16_t*)(ws + WS_KPE), (f32x2*)(ws + WS_ROPE), gw, NGW, fresh_lane());
    }
    END_PH();
    if (IN_PH() && EN(7)) {
        { pg8::EpiStore E{(bf16_t*)(ws + WS_Q), 1536}; GEMM_RUN(pg8::EpiStore, E, ws + WS_ZL, ws + WS_WUQ, T_, 1536, 512, 1024, 512); }
        { pg8::EpiStoreT<1> E{(bf16_t*)(ws + WS_KN), 1024}; GEMM_RUN(pg8::EpiStoreT<1>, E, ws + WS_ZL + 512 * 2, ws + WS_WKN, T_, 1024, 256, 1024, 256); }
        { pg8::EpiStoreT<2> E{(bf16_t*)(ws + WS_VT), T_}; GEMM_RUN(pg8::EpiStoreT<2>, E, ws + WS_WVT, ws + WS_ZL + 512 * 2, 1024, T_, 256, 256, 1024); }
    }
    END_PH();
    if (IN_PH() && EN(8)) {
        for (int v = vcu; v < 256; v += G) {
            const int bh = v >> 1, hf = v & 1;
#pragma unroll 1
            for (int i = 0; i < 4; ++i) {
                const int qb = hf == 0 ? (i == 0 ? 7 : i == 1 ? 0 : i == 2 ? 4 : 3) : (i == 0 ? 6 : i == 1 ? 1 : i == 2 ? 5 : 2);
                att::attn_unit(lds, bh >> 3, bh & 7, qb, (const bf16_t*)(ws + WS_Q), (const bf16_t*)(ws + WS_KN), (const bf16_t*)(ws + WS_KPE), (const bf16_t*)(ws + WS_VT), (const f32x2*)(ws + WS_ROPE), (bf16_t*)(ws + WS_ATT), ws);
            }
        }
    }
    END_PH();
    if (IN_PH() && EN(3)) {
        pg8::Gemm g_{(const bf16_t*)(ws + WS_CONV), (const bf16_t*)(ws + WS_WOUT), T_, D_, 2048, 1024, 2048, (const bf16_t*)(ws + WS_ATT), 16};
        pg8::StaticOrder S_o; S_o.init(T_, D_, G, bx);
        pg8::EpiRes<false, true> E{(const void*)X, X, 1.0f, SS};
        pg8::gemm_phase<pg8::EpiRes<false, true>>(lds, g_, S_o, E);
    }
    END_PH();
    FFN_GU(1, X, (const float*)(SS));
    FFN_DN(1, false, true, X);
    FFN_GU(2, X, (const float*)(SS));
    FFN_DN(2, false, false, X);
    {
        const float* mu = p.in[18];
        if (IN_PH() && EN(9)) mix_phase(X, p.in[17], mu, (bf16_t*)(ws + WS_XR), (bf16_t*)(ws + WS_XWAG), (size_t)T_ * D_, gw, NGW, fresh_lane());
        END_PH();
        if (IN_PH() && EN(10)) { pg8::EpiL1 E{(bf16_t*)(ws + WS_L1)}; GEMM_RUN(pg8::EpiL1, E, ws + WS_XWAG, ws + WS_WL1, 3 * T_, 256, D_, D_, D_); }
        END_PH();
        if (IN_PH() && EN(7)) {
            { pg8::EpiStore E{(bf16_t*)(ws + WS_R), D_}; GEMM_RUN(pg8::EpiStore, E, ws + WS_XR, ws + WS_WR, T_, D_, D_, D_, D_); }
            { pg8::EpiStore E{(bf16_t*)(ws + WS_K), D_}; GEMM_RUN(pg8::EpiStore, E, ws + WS_XK, ws + WS_WK, T_, D_, D_, D_, D_); }
            { pg8::EpiStore E{(bf16_t*)(ws + WS_V), D_}; GEMM_RUN(pg8::EpiStore, E, ws + WS_XV, ws + WS_WV, T_, D_, D_, D_, D_); }
        }
        END_PH();
        if (IN_PH() && EN(11)) { pg8::EpiL2 E{(bf16_t*)(ws + WS_WAG), p.in[23], p.in[26]}; GEMM_RUN(pg8::EpiL2, E, ws + WS_L1, ws + WS_WL2, T_, 3072, 256, 256, 256); }
        END_PH();
        if (IN_PH() && EN(12)) {
            for (int v = vcu; v < 256; v += G)
                scan::scan_unit(lds, v >> 4, v & 15, (const bf16_t*)(ws + WS_R), (const bf16_t*)(ws + WS_K), (const bf16_t*)(ws + WS_V), (const bf16_t*)(ws + WS_WAG),
                                p.in[31], p.in[32], p.in[33], p.in[34], p.in[35], (bf16_t*)(ws + WS_R));
        }
        END_PH();
        if (IN_PH() && EN(3)) { pg8::EpiRes<false, true> E{(const void*)X, X, 1.0f, SS}; GEMM_RUN(pg8::EpiRes<false _C_ true>, E, ws + WS_R, ws + WS_WO, T_, D_, D_, D_, D_); }
        END_PH();
    }
    FFN_GU(3, X, (const float*)(SS));
    if (IN_PH() && EN(3)) { pg8::EpiRes<false, false> E{(const void*)X, (bf16_t*)(ws + WS_XN), 0.5f, SS};
        GEMM_RUN(pg8::EpiRes<false _C_ false>, E, ws + WS_HID, ws + WS_FFN + 3 * FFN_STRIDE + FFN_DN_OFF, T_, D_, FF_, FF_, FF_); }
    END_PH();
    if (IN_PH() && EN(13)) final_norm_phase((const bf16_t*)(ws + WS_XN), 0, p.out, p.in[36], 0, T_, nullptr, nullptr, 0, 0, gw, NGW, fresh_lane());
    END_PH();
    if (PROBE_MASK) {
        unsigned* cw = (unsigned*)(ws + 501 * MiB);
#ifdef PROBE_SYNCS
        { const unsigned long long t0_ = __builtin_amdgcn_s_memrealtime(); for (int q = 0; q < 20; ++q) grid.sync(); t_acc = __builtin_amdgcn_s_memrealtime() - t0_; }
#endif
        if (bx == 0 && tid == 0) __hip_atomic_store(cw, (unsigned)t_acc, __ATOMIC_RELAXED, __HIP_MEMORY_SCOPE_AGENT);
        grid.sync();
        const unsigned ticks = __hip_atomic_load(cw, __ATOMIC_RELAXED, __HIP_MEMORY_SCOPE_AGENT);
        const float dt_us = (float)ticks * 0.01f;
        const float delta = sqrtf(fminf(2e-6f * dt_us, 0.0225f));
        for (int i = bx * 512 + tid; i < (1 << 20); i += G * 512) p.out[i] += delta;
    }
}

static void add_job(Params& p, const float* src, bf16_t* dst, int ldsrc, int c0, int sstride, int G, int lddst, int r0, int dstride, int dk0, int Kc, int Nc, float scale, const float* kscale = nullptr) {
    if (p.njobs >= NJOBS) { fprintf(stderr, "too many jobs\n"); return; }
    Job& j = p.jobs[p.njobs++];
    j.src = src; j.dst = dst; j.kscale = kscale; j.ldsrc = ldsrc; j.c0 = c0; j.sstride = sstride; j.G = G; j.lddst = lddst; j.r0 = r0; j.dstride = dstride; j.dk0 = dk0; j.Kc = Kc; j.Nc = Nc; j.scale = scale;
    j.item0 = p.nitems; p.nitems += (Kc / 64) * (Nc / 32);
}

extern "C" void kernel_launch(void* const* d_in, const int* in_sizes, int n_in, void* d_out, int out_size, void* d_ws, size_t ws_size, hipStream_t stream) {
    static int grid = 0;
    if (grid == 0) {
        if (n_in != 37 || ws_size < WS_END) { fprintf(stderr, "kernel_launch: unexpected n_in %d / ws %zu\n", n_in, ws_size); grid = -1; return; }
        int dev = 0, cus = 0, per_cu = 0;
        (void)hipGetDevice(&dev); (void)hipDeviceGetAttribute(&cus, hipDeviceAttributeMultiprocessorCount, dev);
        if (hipFuncSetAttribute((const void*)mega_fwd, hipFuncAttributeMaxDynamicSharedMemorySize, LDS_BYTES) != hipSuccess) { fprintf(stderr, "hipFuncSetAttribute failed\n"); grid = -1; return; }
        if (hipOccupancyMaxActiveBlocksPerMultiprocessor(&per_cu, (const void*)mega_fwd, 512, LDS_BYTES) != hipSuccess || per_cu < 1) { fprintf(stderr, "occupancy query: %d\n", per_cu); per_cu = 1; }
        (void)hipGetLastError();
        grid = cus * 1;
        if (grid > 256) grid = 256;
    }
    if (grid < 0) return;
    Params p; memset(&p, 0, sizeof(p));
    for (int i = 0; i < 37; ++i) p.in[i] = (const float*)d_in[i];
    p.out = (float*)d_out; p.ws = (unsigned char*)d_ws;
    unsigned char* ws = (unsigned char*)d_ws;
    for (int f = 0; f < 4; ++f) {
        const float* wg = p.in[3] + (size_t)f * D_ * FF_; const float* wu = p.in[4] + (size_t)f * D_ * FF_; const float* wd = p.in[5] + (size_t)f * FF_ * D_;
        bf16_t* gu = (bf16_t*)(ws + WS_FFN + f * FFN_STRIDE); bf16_t* dn = (bf16_t*)(ws + WS_FFN + f * FFN_STRIDE + FFN_DN_OFF);
        const float* ng = f == 0 ? nullptr : p.in[2] + (size_t)f * D_;
        add_job(p, wg, gu, FF_, 0, 128, 128, D_, 0, 256, 0, D_, FF_, 1.f, ng);
        add_job(p, wu, gu, FF_, 0, 128, 128, D_, 128, 256, 0, D_, FF_, 1.f, ng);
        add_job(p, wd, dn, D_, 0, 0, D_, FF_, 0, 0, 0, FF_, D_, 1.f);
    }
    { bf16_t* w = (bf16_t*)(ws + WS_WIN);
      add_job(p, p.in[7], w, 2880, 0, 128, 128, D_, 0, 256, 0, D_, 1024, 1.f, p.in[6]);
      add_job(p, p.in[7], w, 2880, 1024, 128, 128, D_, 128, 256, 0, D_, 1024, 1.f, p.in[6]);
      add_job(p, p.in[7], w, 2880, 2048, 0, 832, D_, 2048, 0, 0, D_, 832, 1.f, p.in[6]);
      add_job(p, nullptr, w, 0, 0, 0, 192, D_, 2880, 0, 0, D_, 192, 1.f); }
    add_job(p, p.in[13], (bf16_t*)(ws + WS_WUQ), 1536, 0, 0, 1536, 512, 0, 0, 0, 512, 1536, 0.07216878364870322f * 1.4426950408889634f);
    add_job(p, p.in[15], (bf16_t*)(ws + WS_WKN), 2048, 0, 256, 128, 256, 0, 128, 0, 256, 1024, 1.f);
    add_job(p, p.in[15], (bf16_t*)(ws + WS_WVT), 2048, 128, 256, 128, 256, 0, 128, 0, 256, 1024, 1.f);
    add_job(p, p.in[16], (bf16_t*)(ws + WS_WOUT), 1024, 0, 0, 1024, 2048, 0, 0, 0, 2048, 1024, 1.f);
    add_job(p, p.in[19], (bf16_t*)(ws + WS_WR), 1024, 0, 0, 1024, 1024, 0, 0, 0, 1024, 1024, 1.f);
    add_job(p, p.in[20], (bf16_t*)(ws + WS_WK), 1024, 0, 0, 1024, 1024, 0, 0, 0, 1024, 1024, 1.f);
    add_job(p, p.in[21], (bf16_t*)(ws + WS_WV), 1024, 0, 0, 1024, 1024, 0, 0, 0, 1024, 1024, 1.f);
    add_job(p, p.in[22], (bf16_t*)(ws + WS_WO), 1024, 0, 0, 1024, 1024, 0, 0, 0, 1024, 1024, 1.f);
    { bf16_t* w = (bf16_t*)(ws + WS_WL1);
      add_job(p, p.in[24], w, 64, 0, 0, 64, 1024, 0, 0, 0, 1024, 64, 1.f);
      add_job(p, p.in[27], w, 64, 0, 0, 64, 1024, 64, 0, 0, 1024, 64, 1.f);
      add_job(p, p.in[29], w, 128, 0, 0, 128, 1024, 128, 0, 0, 1024, 128, 1.f); }
    { bf16_t* w = (bf16_t*)(ws + WS_WL2);
      add_job(p, p.in[25], w, 1024, 0, 0, 1024, 256, 0, 0, 0, 64, 1024, 1.f);
      add_job(p, p.in[28], w, 1024, 0, 0, 1024, 256, 1024, 0, 64, 64, 1024, 1.f);
      add_job(p, p.in[30], w, 1024, 0, 0, 1024, 256, 2048, 0, 128, 128, 1024, 1.f);
      add_job(p, nullptr, w, 0, 0, 0, 1024, 256, 0, 0, 64, 192, 1024, 1.f);
      add_job(p, nullptr, w, 0, 0, 0, 1024, 256, 1024, 0, 0, 64, 1024, 1.f);
      add_job(p, nullptr, w, 0, 0, 0, 1024, 256, 1024, 0, 128, 128, 1024, 1.f);
      add_job(p, nullptr, w, 0, 0, 0, 1024, 256, 2048, 0, 0, 128, 1024, 1.f); }
    p.ph_lo = 0; p.ph_hi = N_PHASES;
    void* args[] = {&p};
    hipError_t e = hipLaunchCooperativeKernel((const void*)mega_fwd, dim3(grid), dim3(512), args, LDS_BYTES, stream);
    if (e != hipSuccess) fprintf(stderr, "cooperative launch failed: %s (grid %d)\n", hipGetErrorString(e), grid);
}
```
